# Optimizing an MI355X kernel written in HIP

```python
import math
import jax, jax.numpy as jnp
from jax import lax
import numpy as np

D_MODEL = 2048
BATCH = 1
SEQ = 8192
DEPTH = 1

ATT_WIDTH = D_MODEL // 2
V_HEAD_DIM = 128
N_ATT_HEADS = ATT_WIDTH // V_HEAD_DIM
QK_HEAD_DIM = V_HEAD_DIM // 2
Q_WIDTH = 2 * N_ATT_HEADS * QK_HEAD_DIM
K_WIDTH = Q_WIDTH
LAMBDA_INIT_BASE = 0.8
LAMBDA_INIT_AMP = 0.6
LAMBDA_INIT_RATE = 0.3
POOL_WIDTH = D_MODEL // 2
POOL_WINDOWS = (2, 4, 8, 16)
POOL_GROUPS = len(POOL_WINDOWS)
POOL_GROUP_WIDTH = POOL_WIDTH // POOL_GROUPS
IN_WIDTH = Q_WIDTH + K_WIDTH + ATT_WIDTH + POOL_WIDTH + 2 * D_MODEL
D_FF = 4 * D_MODEL
PLE_DIM = 256
Q_BLOCK = 128
NORM_EPS = 1e-6

kernel_name = "hybrid_diffattn_pool_gated_block"


def rms_norm(x, g):
    xf = x.astype(jnp.float32)
    y = xf * lax.rsqrt(jnp.mean(xf * xf, axis=-1, keepdims=True) + NORM_EPS)
    return (y * g.astype(jnp.float32)).astype(x.dtype)


def alibi_slopes(n_heads):
    return jnp.asarray(2.0 ** (-8.0 * np.arange(1, n_heads + 1) / n_heads), dtype=jnp.float32)


def diff_attention(q1, q2, k1, k2, v, lam):
    B, H, S, _ = k1.shape
    nb = S // Q_BLOCK
    scale = QK_HEAD_DIM ** -0.5
    slopes = alibi_slopes(H)
    key_pos = jnp.arange(S)

    def to_blocks(q):
        return (q * scale).reshape(B, H, nb, Q_BLOCK, -1).transpose(2, 0, 1, 3, 4)

    def one_block(args):
        qb1, qb2, start = args
        q_pos = start + jnp.arange(Q_BLOCK)
        dist = q_pos[:, None] - key_pos[None, :]
        bias = -slopes[:, None, None] * dist.astype(jnp.float32)
        causal = dist >= 0

        def probs(qb, k):
            s = jnp.einsum('bhqd,bhkd->bhqk', qb, k).astype(jnp.float32) + bias
            s = jnp.where(causal, s, -jnp.inf)
            return jax.nn.softmax(s, axis=-1)

        a = probs(qb1, k1) - lam * probs(qb2, k2)
        return jnp.einsum('bhqk,bhkv->bhqv', a.astype(v.dtype), v)

    starts = jnp.arange(nb) * Q_BLOCK
    out = lax.map(one_block, (to_blocks(q1), to_blocks(q2), starts))
    return out.transpose(1, 2, 0, 3, 4).reshape(B, H, S, V_HEAD_DIM)


def multiscale_pool(u):
    B, S, C = u.shape
    uf = u.astype(jnp.float32)
    csum = jnp.cumsum(uf, axis=1)
    t = jnp.arange(S)
    outs = []
    for g, w in enumerate(POOL_WINDOWS):
        sl = slice(g * POOL_GROUP_WIDTH, (g + 1) * POOL_GROUP_WIDTH)
        cg = csum[..., sl]
        lagged = jnp.pad(cg, ((0, 0), (w, 0), (0, 0)))[:, :S]
        count = jnp.minimum(t + 1, w).astype(jnp.float32)[None, :, None]
        outs.append((cg - lagged) / count - uf[..., sl])
    return jnp.stack(outs, axis=2).astype(u.dtype)


def setup_inputs(seed: int = 0) -> dict:
    key = jax.random.key(seed)
    ks = jax.random.split(key, 24)
    f32 = jnp.float32

    def w(k, shape, fan_in):
        return jax.random.normal(k, shape, f32) * (fan_in ** -0.5)

    def gain(k, shape):
        return 1.0 + 0.02 * jax.random.normal(k, shape, f32)

    return {
        "x": jax.random.normal(ks[0], (BATCH, SEQ, D_MODEL), f32),
        "p": jax.random.normal(ks[1], (DEPTH, BATCH, SEQ, PLE_DIM), f32),
        "norm_mix_g": gain(ks[2], (DEPTH, D_MODEL)),
        "w_in": w(ks[3], (DEPTH, D_MODEL, IN_WIDTH), D_MODEL),
        "lambda_q1": 0.1 * jax.random.normal(ks[4], (DEPTH, QK_HEAD_DIM), f32),
        "lambda_k1": 0.1 * jax.random.normal(ks[5], (DEPTH, QK_HEAD_DIM), f32),
        "lambda_q2": 0.1 * jax.random.normal(ks[6], (DEPTH, QK_HEAD_DIM), f32),
        "lambda_k2": 0.1 * jax.random.normal(ks[7], (DEPTH, QK_HEAD_DIM), f32),
        "subln_g": gain(ks[8], (DEPTH, V_HEAD_DIM)),
        "pool_grp_w": w(ks[9], (DEPTH, POOL_GROUPS, POOL_GROUP_WIDTH, POOL_GROUP_WIDTH), POOL_GROUP_WIDTH),
        "pool_scale": gain(ks[10], (DEPTH, POOL_WIDTH)),
        "w_attn_br": w(ks[11], (DEPTH, ATT_WIDTH, D_MODEL), ATT_WIDTH),
        "w_pool_br": w(ks[12], (DEPTH, POOL_WIDTH, D_MODEL), POOL_WIDTH),
        "w_out": w(ks[13], (DEPTH, D_MODEL, D_MODEL), D_MODEL),
        "norm_mlp_g": gain(ks[14], (DEPTH, D_MODEL)),
        "w_mlp_up": w(ks[15], (DEPTH, D_MODEL, D_FF), D_MODEL),
        "w_mlp_down": w(ks[16], (DEPTH, D_FF, D_MODEL), D_FF),
        "norm_ple_g": gain(ks[17], (DEPTH, D_MODEL)),
        "w_ple": w(ks[18], (DEPTH, PLE_DIM, D_MODEL), PLE_DIM),
        "w_ple_gate": w(ks[19], (DEPTH, D_MODEL, D_MODEL), D_MODEL),
        "final_norm_g": gain(ks[20], (D_MODEL,)),
    }


def reference(x, p, norm_mix_g, w_in, lambda_q1, lambda_k1, lambda_q2, lambda_k2, subln_g,
              pool_grp_w, pool_scale, w_attn_br, w_pool_br, w_out, norm_mlp_g, w_mlp_up,
              w_mlp_down, norm_ple_g, w_ple, w_ple_gate, final_norm_g):
    B, S, _ = x.shape
    H, dqk = N_ATT_HEADS, QK_HEAD_DIM
    o_q = 0
    o_k = o_q + Q_WIDTH
    o_v = o_k + K_WIDTH
    o_u = o_v + ATT_WIDTH
    o_ga = o_u + POOL_WIDTH
    o_gp = o_ga + D_MODEL
    for i in range(DEPTH):
        h = rms_norm(x, norm_mix_g[i])
        z = h @ w_in[i]
        q = z[..., o_q:o_k].reshape(B, S, 2, H, dqk).transpose(2, 0, 3, 1, 4)
        k = z[..., o_k:o_v].reshape(B, S, 2, H, dqk).transpose(2, 0, 3, 1, 4)
        v = z[..., o_v:o_u].reshape(B, S, H, V_HEAD_DIM).transpose(0, 2, 1, 3)
        u = z[..., o_u:o_ga]
        gate_a = jax.nn.sigmoid(z[..., o_ga:o_gp])
        gate_p = jax.nn.sigmoid(z[..., o_gp:])

        lam_init = LAMBDA_INIT_BASE - LAMBDA_INIT_AMP * math.exp(-LAMBDA_INIT_RATE * i)
        lam = (jnp.exp(jnp.sum(lambda_q1[i].astype(jnp.float32) * lambda_k1[i].astype(jnp.float32)))
               - jnp.exp(jnp.sum(lambda_q2[i].astype(jnp.float32) * lambda_k2[i].astype(jnp.float32)))
               + lam_init)
        o = diff_attention(q[0], q[1], k[0], k[1], v, lam)
        o = rms_norm(o, subln_g[i]) * (1.0 - lam_init)
        o = o.transpose(0, 2, 1, 3).reshape(B, S, ATT_WIDTH)
        a_branch = o @ w_attn_br[i]

        pooled = multiscale_pool(u)
        pm = jnp.einsum('bsgc,gcd->bsgd', pooled, pool_grp_w[i]).reshape(B, S, POOL_WIDTH)
        p_branch = (pm * pool_scale[i]) @ w_pool_br[i]

        merged = gate_a * a_branch + gate_p * p_branch
        x = x + merged @ w_out[i]

        hm = rms_norm(x, norm_mlp_g[i])
        x = x + jnp.square(jax.nn.relu(hm @ w_mlp_up[i])) @ w_mlp_down[i]

        ple_gate = jax.nn.sigmoid(rms_norm(x, norm_ple_g[i]) @ w_ple_gate[i])
        x = x + (p[i] @ w_ple[i]) * ple_gate
    return rms_norm(x, final_norm_g)
```

```cpp
#include <hip/hip_runtime.h>
#include <hip/hip_cooperative_groups.h>
#include <cstdio>
#include <cstdint>
namespace cg = cooperative_groups;

namespace pg8 {
#define PG8_LAS __attribute__((address_space(3)))
typedef unsigned short bf16_t;
typedef short bf16x8 __attribute__((ext_vector_type(8)));
typedef float f32x4 __attribute__((ext_vector_type(4)));
typedef unsigned u32x4 __attribute__((ext_vector_type(4)));
constexpr int BM = 256, BK = 64, HALF = 128, HTB = HALF * BK * 2  , STAGE_BYTES = 8 * HTB, NXCD = 8, WGM = 8;

__host__ __device__ __forceinline__ int lds_byte(int r, int c) { const int st = (r >> 4) * 2 + (c >> 5), rr = r & 15, cc = c & 31, ob = rr * 64 + cc * 2; return st * 1024 + (ob ^ (((ob >> 9) & 1) << 5)); }
__host__ __device__ __forceinline__ void stage_rc(int b, int& R, int& C) { const int st = b / 1024, sb = b % 1024, swz = sb ^ (((sb >> 9) & 1) << 5); R = (st >> 1) * 16 + swz / 64; C = (st & 1) * 32 + (swz % 64) / 2; }
__host__ __device__ __forceinline__ int perm32(int rho) { const int n = rho >> 4, i = rho & 15; return 8 * (i >> 2) + 4 * n + (i & 3); }

struct Unit { int pm, pn, g; };
struct Gemm { const bf16_t* A; const bf16_t* Bt; int M, N, K, lda, ldb; size_t gsA, gsB; };

struct StaticOrder {
    int nM, nN, nwg, G, c;
    __host__ __device__ void init(int M, int N, int G_, int c_) { nM = M / BM; nN = N / BM; nwg = nM * nN; G = G_; c = c_; }
    __host__ __device__ bool next(int i, Unit& u) const {
        const long L = (long)i * G + c; if (L >= nwg) return false;
        int wgid = (int)L; { const int q = nwg / NXCD, r = nwg % NXCD, xcd = wgid % NXCD, off = wgid / NXCD; wgid = (xcd < r ? xcd * (q + 1) : r * (q + 1) + (xcd - r) * q) + off; }
        const int nig = WGM * nN, gid = wgid / nig, fm = gid * WGM, gsz = (nM - fm) < WGM ? (nM - fm) : WGM;
        u.pm = fm + ((wgid % nig) % gsz); u.pn = (wgid % nig) / gsz; u.g = 0; return true;
    }
    __device__ __forceinline__ void a_ready(const Unit&) const {}
    __device__ __forceinline__ void done(const Unit&) const {}
};

__device__ __forceinline__ unsigned cvt_pk_bf16(float lo, float hi) { unsigned r; asm volatile("v_cvt_pk_bf16_f32 %0, %1, %2" : "=v"(r) : "v"(lo), "v"(hi)); return r; }
typedef unsigned u32x2 __attribute__((ext_vector_type(2)));
__device__ __forceinline__ float bf_lo(unsigned w) { return __uint_as_float(w << 16); }
__device__ __forceinline__ float bf_hi(unsigned w) { return __uint_as_float(w & 0xffff0000u); }
__device__ __forceinline__ float sigm(float v) { return __builtin_amdgcn_rcpf(1.f + __builtin_amdgcn_exp2f(-1.4426950408889634f * v)); }
__device__ __forceinline__ u32x4 pack8(const f32x4& v0, const f32x4& v1) { u32x4 w; w.x = cvt_pk_bf16(v0[0], v0[1]); w.y = cvt_pk_bf16(v0[2], v0[3]); w.z = cvt_pk_bf16(v1[0], v1[1]); w.w = cvt_pk_bf16(v1[2], v1[3]); return w; }
__device__ __forceinline__ void unpack8(const u32x4& g, f32x4& a, f32x4& b) { a = (f32x4){bf_lo(g.x), bf_hi(g.x), bf_lo(g.y), bf_hi(g.y)}; b = (f32x4){bf_lo(g.z), bf_hi(g.z), bf_lo(g.w), bf_hi(g.w)}; }
__device__ __forceinline__ float sq4(const f32x4& v) { return (v[0] * v[0] + v[1] * v[1]) + (v[2] * v[2] + v[3] * v[3]); }
constexpr int SEQ_ = 8192;
#define EPI_LOOP_ROWS _Pragma("unroll") for (int ai = 0; ai < 2; ++ai) _Pragma("unroll") for (int m = 0; m < 4; ++m)
#define EPI_LOOP_BJ _Pragma("unroll") for (int bj = 0; bj < 2; ++bj)

struct EpiInProj { static constexpr bool PERM = true, AFTER_DRAIN = false, MIDK = false;
    bf16_t* Z; bf16_t* G; float qscale; unsigned* nmax;
    __device__ __forceinline__ void operator()(const f32x4 (&acc)[2][2][4][2], const Unit& u, int wr, int wc, int fr, int fq) const {
        const int colt = u.pn * BM, reg = colt >> 10; const bool sig = reg >= 4;
        bf16_t* base; int ldc, c0; float sc = 1.f;
        if (!sig) { base = Z + (size_t)reg * ((size_t)SEQ_ * 1024); ldc = 1024; c0 = colt & 1023; if (reg == 0) sc = qscale; }
        else { const int gi = (reg - 4) >> 1; base = G + (size_t)gi * ((size_t)SEQ_ * 2048); ldc = 2048; c0 = colt - 4096 - gi * 2048; }
        const int col0 = c0 + wc * 32 + 8 * fq, row0 = u.pm * BM + wr * 64 + fr;
        float mx[2] = {0.f, 0.f};
        EPI_LOOP_ROWS { bf16_t* rowp = base + (size_t)(row0 + ai * HALF + m * 16) * ldc + col0;
            EPI_LOOP_BJ { f32x4 v0 = acc[ai][bj][m][0], v1 = acc[ai][bj][m][1];
                if (sig) {
#pragma unroll
                    for (int i = 0; i < 4; ++i) { v0[i] = sigm(v0[i]); v1[i] = sigm(v1[i]); } }
                else { v0 = v0 * sc; v1 = v1 * sc; }
                if (reg <= 1) { float s = sq4(v0) + sq4(v1); s += __shfl_xor(s, 16); s += __shfl_xor(s, 32); mx[bj] = fmaxf(mx[bj], s); }
                *(u32x4*)(rowp + bj * HALF) = pack8(v0, v1); } }
        if (reg <= 1) {
            EPI_LOOP_BJ { float v = mx[bj]; v = fmaxf(v, __shfl_xor(v, 1)); v = fmaxf(v, __shfl_xor(v, 2)); v = fmaxf(v, __shfl_xor(v, 4)); v = fmaxf(v, __shfl_xor(v, 8));
                const int cg_ = c0 + bj * HALF + wc * 32;
                if (fr == 0 && fq == 0) atomicMax(nmax + (reg * 16 + (cg_ >> 6)) * 2 + ((cg_ >> 5) & 1), __float_as_uint(v)); }
        }
    }
};
struct EpiBf16G { static constexpr bool PERM = true, AFTER_DRAIN = false, MIDK = false;
    bf16_t* O; int ldc; int gcols;
    __device__ __forceinline__ void operator()(const f32x4 (&acc)[2][2][4][2], const Unit& u, int wr, int wc, int fr, int fq) const {
        const int col0 = u.g * gcols + u.pn * BM + wc * 32 + 8 * fq, row0 = u.pm * BM + wr * 64 + fr;
        EPI_LOOP_ROWS { bf16_t* rowp = O + (size_t)(row0 + ai * HALF + m * 16) * ldc + col0;
            EPI_LOOP_BJ { *(u32x4*)(rowp + bj * HALF) = pack8(acc[ai][bj][m][0], acc[ai][bj][m][1]); } }
    }
};
struct EpiGateA { static constexpr bool PERM = true, AFTER_DRAIN = false, MIDK = false;
    const bf16_t* GA; bf16_t* T;
    __device__ __forceinline__ void operator()(const f32x4 (&acc)[2][2][4][2], const Unit& u, int wr, int wc, int fr, int fq) const {
        const int col0 = u.pn * BM + wc * 32 + 8 * fq, row0 = u.pm * BM + wr * 64 + fr;
        EPI_LOOP_ROWS { const size_t off = (size_t)(row0 + ai * HALF + m * 16) * 2048 + col0;
            EPI_LOOP_BJ { const u32x4 g = *(const u32x4*)(GA + off + bj * HALF); f32x4 g0, g1; unpack8(g, g0, g1);
                *(u32x4*)(T + off + bj * HALF) = pack8(acc[ai][bj][m][0] * g0, acc[ai][bj][m][1] * g1); } asm volatile("" ::: "memory"); }
    }
};
struct EpiGateP { static constexpr bool PERM = true, AFTER_DRAIN = false, MIDK = false;
    const bf16_t* GP; const bf16_t* T; bf16_t* MG;
    __device__ __forceinline__ void operator()(const f32x4 (&acc)[2][2][4][2], const Unit& u, int wr, int wc, int fr, int fq) const {
        const int col0 = u.pn * BM + wc * 32 + 8 * fq, row0 = u.pm * BM + wr * 64 + fr;
        EPI_LOOP_ROWS { const size_t off = (size_t)(row0 + ai * HALF + m * 16) * 2048 + col0;
            EPI_LOOP_BJ { const u32x4 g = *(const u32x4*)(GP + off + bj * HALF); f32x4 g0, g1; unpack8(g, g0, g1);
                const u32x4 tt = *(const u32x4*)(T + off + bj * HALF); f32x4 t0, t1; unpack8(tt, t0, t1);
                *(u32x4*)(MG + off + bj * HALF) = pack8(t0 + acc[ai][bj][m][0] * g0, t1 + acc[ai][bj][m][1] * g1); } asm volatile("" ::: "memory"); }
    }
};
template <bool BASE_BF16> struct EpiResid { static constexpr bool PERM = true, AFTER_DRAIN = false, MIDK = false;
    const void* base; bf16_t* outb; float* ss;
    __device__ __forceinline__ void operator()(const f32x4 (&acc)[2][2][4][2], const Unit& u, int wr, int wc, int fr, int fq) const {
        const int col0 = u.pn * BM + wc * 32 + 8 * fq, row0 = u.pm * BM + wr * 64 + fr;
        EPI_LOOP_ROWS { const int row = row0 + ai * HALF + m * 16; const size_t off = (size_t)row * 2048 + col0; float s = 0.f;
            EPI_LOOP_BJ { f32x4 b0, b1;
                if (BASE_BF16) { const u32x4 bb = *(const u32x4*)((const bf16_t*)base + off + bj * HALF); unpack8(bb, b0, b1); }
                else { b0 = __builtin_nontemporal_load((const f32x4*)((const float*)base + off + bj * HALF)); b1 = __builtin_nontemporal_load((const f32x4*)((const float*)base + off + bj * HALF + 4)); }
                const f32x4 o0 = b0 + acc[ai][bj][m][0], o1 = b1 + acc[ai][bj][m][1];
                *(u32x4*)(outb + off + bj * HALF) = pack8(o0, o1); s += sq4(o0) + sq4(o1); }
            s += __shfl_xor(s, 16); s += __shfl_xor(s, 32); if (fq == 0) unsafeAtomicAdd(ss + row, s); asm volatile("" ::: "memory"); }
    }
};
struct EpiUp { static constexpr bool PERM = true, AFTER_DRAIN = false, MIDK = false;
    bf16_t* H; const float* ss;
    __device__ __forceinline__ void operator()(const f32x4 (&acc)[2][2][4][2], const Unit& u, int wr, int wc, int fr, int fq) const {
        const int col0 = u.pn * BM + wc * 32 + 8 * fq, row0 = u.pm * BM + wr * 64 + fr;
        EPI_LOOP_ROWS { const int row = row0 + ai * HALF + m * 16; const float rs = __builtin_amdgcn_rsqf(ss[row] * (1.f / 2048.f) + 1e-6f);
            EPI_LOOP_BJ { f32x4 v0 = acc[ai][bj][m][0] * rs, v1 = acc[ai][bj][m][1] * rs;
#pragma unroll
                for (int i = 0; i < 4; ++i) { const float a = fmaxf(v0[i], 0.f), b = fmaxf(v1[i], 0.f); v0[i] = a * a; v1[i] = b * b; }
                *(u32x4*)(H + (size_t)row * 8192 + col0 + bj * HALF) = pack8(v0, v1); } }
    }
};
struct EpiStoreF32 { static constexpr bool PERM = true, AFTER_DRAIN = false, MIDK = false;
    float* out;
    __device__ __forceinline__ void operator()(const f32x4 (&acc)[2][2][4][2], const Unit& u, int wr, int wc, int fr, int fq) const {
        const int col0 = u.pn * BM + wc * 32 + 8 * fq, row0 = u.pm * BM + wr * 64 + fr;
        EPI_LOOP_ROWS { const size_t off = (size_t)(row0 + ai * HALF + m * 16) * 2048 + col0;
            EPI_LOOP_BJ { *(f32x4*)(out + off + bj * HALF) = acc[ai][bj][m][0]; *(f32x4*)(out + off + bj * HALF + 4) = acc[ai][bj][m][1]; } }
    }
};
struct EpiStoreBf16 { static constexpr bool PERM = true, AFTER_DRAIN = false, MIDK = false;
    bf16_t* out;
    __device__ __forceinline__ void operator()(const f32x4 (&acc)[2][2][4][2], const Unit& u, int wr, int wc, int fr, int fq) const {
        const int col0 = u.pn * BM + wc * 32 + 8 * fq, row0 = u.pm * BM + wr * 64 + fr;
        EPI_LOOP_ROWS { const size_t off = (size_t)(row0 + ai * HALF + m * 16) * 2048 + col0;
            EPI_LOOP_BJ { *(u32x4*)(out + off + bj * HALF) = pack8(acc[ai][bj][m][0], acc[ai][bj][m][1]); } }
    }
};
struct EpiPleGate { static constexpr bool PERM = true, AFTER_DRAIN = false, MIDK = false;
    const bf16_t* pe; const bf16_t* xb; float* out; const float* ss_in; float* ss_out;
    __device__ __forceinline__ void operator()(const f32x4 (&acc)[2][2][4][2], const Unit& u, int wr, int wc, int fr, int fq) const {
        const int col0 = u.pn * BM + wc * 32 + 8 * fq, row0 = u.pm * BM + wr * 64 + fr;
        EPI_LOOP_ROWS { const int row = row0 + ai * HALF + m * 16; const size_t off = (size_t)row * 2048 + col0; float s = 0.f;
            const float rs = __builtin_amdgcn_rsqf(ss_in[row] * (1.f / 2048.f) + 1e-6f);
            EPI_LOOP_BJ { f32x4 g0 = acc[ai][bj][m][0] * rs, g1 = acc[ai][bj][m][1] * rs;
#pragma unroll
                for (int i = 0; i < 4; ++i) { g0[i] = sigm(g0[i]); g1[i] = sigm(g1[i]); }
                const u32x4 xx = *(const u32x4*)(xb + off + bj * HALF), pp = *(const u32x4*)(pe + off + bj * HALF); f32x4 x0, x1, p0, p1; unpack8(xx, x0, x1); unpack8(pp, p0, p1);
                const f32x4 o0 = x0 + p0 * g0, o1 = x1 + p1 * g1;
                *(f32x4*)(out + off + bj * HALF) = o0; *(f32x4*)(out + off + bj * HALF + 4) = o1; s += sq4(o0) + sq4(o1); }
            s += __shfl_xor(s, 16); s += __shfl_xor(s, 32); if (fq == 0) unsafeAtomicAdd(ss_out + row, s); asm volatile("" ::: "memory"); }
    }
};
struct EpiPleGateFinal { static constexpr bool PERM = true, AFTER_DRAIN = true, MIDK = false;
    const bf16_t* pe; const bf16_t* xb; float* out; const float* ss_in; float* ss_out; unsigned* cnt; const float* fg;
    __device__ __forceinline__ void fused(f32x4 (&acc)[2][2][4][2], const Unit& u, int wr, int wc, int fr, int fq, PG8_LAS unsigned char* lds, int wid, int lane) const {
        const int col0 = u.pn * BM + wc * 32 + 8 * fq, row0 = u.pm * BM + wr * 64 + fr;
        EPI_LOOP_ROWS { const int row = row0 + ai * HALF + m * 16; const size_t off = (size_t)row * 2048 + col0; float s = 0.f;
            const float rs = __builtin_amdgcn_rsqf(ss_in[row] * (1.f / 2048.f) + 1e-6f);
            EPI_LOOP_BJ { f32x4 g0 = acc[ai][bj][m][0] * rs, g1 = acc[ai][bj][m][1] * rs;
#pragma unroll
                for (int i = 0; i < 4; ++i) { g0[i] = sigm(g0[i]); g1[i] = sigm(g1[i]); }
                const u32x4 xx = *(const u32x4*)(xb + off + bj * HALF), pp = *(const u32x4*)(pe + off + bj * HALF); f32x4 x0, x1, p0, p1; unpack8(xx, x0, x1); unpack8(pp, p0, p1);
                const f32x4 o0 = x0 + p0 * g0, o1 = x1 + p1 * g1; acc[ai][bj][m][0] = o0; acc[ai][bj][m][1] = o1; s += sq4(o0) + sq4(o1); }
            s += __shfl_xor(s, 16); s += __shfl_xor(s, 32); if (fq == 0) unsafeAtomicAdd(ss_out + row, s); asm volatile("" ::: "memory"); }
        asm volatile("s_waitcnt vmcnt(0)" ::: "memory");
        __syncthreads();
        if (threadIdx.x == 0) { __hip_atomic_fetch_add(cnt + u.pm, 1u, __ATOMIC_RELAXED, __HIP_MEMORY_SCOPE_AGENT); unsigned sp = 0;
            while (__hip_atomic_load(cnt + u.pm, __ATOMIC_RELAXED, __HIP_MEMORY_SCOPE_AGENT) < 8u) { __builtin_amdgcn_s_sleep(1); if (++sp > (1u << 22)) break; } }
        __syncthreads();
        EPI_LOOP_ROWS { const int row = row0 + ai * HALF + m * 16; const size_t off = (size_t)row * 2048 + col0;
            const float t = __uint_as_float(__hip_atomic_load((unsigned*)(ss_out + row), __ATOMIC_RELAXED, __HIP_MEMORY_SCOPE_AGENT)); const float rs = 1.f / sqrtf(t * (1.f / 2048.f) + 1e-6f);
            EPI_LOOP_BJ { const f32x4 ga = *(const f32x4*)(fg + col0 + bj * HALF), gb = *(const f32x4*)(fg + col0 + bj * HALF + 4);
                *(f32x4*)(out + off + bj * HALF) = acc[ai][bj][m][0] * rs * ga; *(f32x4*)(out + off + bj * HALF + 4) = acc[ai][bj][m][1] * rs * gb; } }
    }
};
struct EpiMerged { static constexpr bool PERM = true, AFTER_DRAIN = false, MIDK = true;
    const bf16_t* GA; const bf16_t* GP; bf16_t* MG;
    __device__ __forceinline__ void mid(f32x4 (&acc)[2][2][4][2], const Unit& u, int wr, int wc, int fr, int fq) const {
        const int col0 = u.pn * BM + wc * 32 + 8 * fq, row0 = u.pm * BM + wr * 64 + fr;
        unsigned long long ro_ = ((unsigned long long)row0 * 2048 + col0) * 2; asm volatile("" : "+v"(ro_));
        const bf16_t* ga = (const bf16_t*)((const char*)GA + ro_); const bf16_t* gp = (const bf16_t*)((const char*)GP + ro_);
#pragma unroll
        for (int ai = 0; ai < 2; ++ai)
#pragma unroll
            for (int m = 0; m < 4; ++m)
#pragma unroll
                for (int bj = 0; bj < 2; ++bj) { const size_t o_ = (size_t)(ai * HALF + m * 16) * 2048 + bj * HALF;
                    const u32x4 a = *(const u32x4*)(ga + o_), p = *(const u32x4*)(gp + o_);
#define RT_(aw, pw, lo) ((lo ? bf_lo(aw) : bf_hi(aw)) * __builtin_amdgcn_rcpf(fmaxf(lo ? bf_lo(pw) : bf_hi(pw), 1e-30f)))
                    acc[ai][bj][m][0][0] *= RT_(a.x, p.x, 1); acc[ai][bj][m][0][1] *= RT_(a.x, p.x, 0); acc[ai][bj][m][0][2] *= RT_(a.y, p.y, 1); acc[ai][bj][m][0][3] *= RT_(a.y, p.y, 0);
                    acc[ai][bj][m][1][0] *= RT_(a.z, p.z, 1); acc[ai][bj][m][1][1] *= RT_(a.z, p.z, 0); acc[ai][bj][m][1][2] *= RT_(a.w, p.w, 1); acc[ai][bj][m][1][3] *= RT_(a.w, p.w, 0);
#undef RT_
                    asm volatile("" ::: "memory"); }
    }
    __device__ __forceinline__ void operator()(const f32x4 (&acc)[2][2][4][2], const Unit& u, int wr, int wc, int fr, int fq) const {
        const int col0 = u.pn * BM + wc * 32 + 8 * fq, row0 = u.pm * BM + wr * 64 + fr;
        EPI_LOOP_ROWS { const size_t off = (size_t)(row0 + ai * HALF + m * 16) * 2048 + col0;
            EPI_LOOP_BJ { const u32x4 g = *(const u32x4*)(GP + off + bj * HALF); f32x4 g0, g1; unpack8(g, g0, g1);
                *(u32x4*)(MG + off + bj * HALF) = pack8(acc[ai][bj][m][0] * g0, acc[ai][bj][m][1] * g1); } asm volatile("" ::: "memory"); }
    }
};
struct EpiDummy { static constexpr bool PERM = true, AFTER_DRAIN = false, MIDK = false;
    bf16_t* O;
    __device__ __forceinline__ void operator()(const f32x4 (&acc)[2][2][4][2], const Unit& u, int wr, int wc, int fr, int fq) const {
        const int col0 = (u.pn & 7) * BM + wc * 32 + 8 * fq, row0 = (u.pm & 7) * BM + wr * 64 + fr;
        EPI_LOOP_ROWS { bf16_t* rowp = O + (size_t)(row0 + ai * HALF + m * 16) * 2048 + col0;
            EPI_LOOP_BJ { *(u32x4*)(rowp + bj * HALF) = pack8(acc[ai][bj][m][0], acc[ai][bj][m][1]); } }
    }
};
struct SubOrder { StaticOrder so; int base, cnt;
    __host__ __device__ bool next(int i, Unit& u) const { return i < cnt ? so.next(base + i, u) : false; }
    __device__ __forceinline__ void a_ready(const Unit&) const {}
    __device__ __forceinline__ void done(const Unit&) const {}
};
struct GroupOrder {
    int G, c;
    __host__ __device__ bool next(int i, Unit& u) const { const int L = i * G + c; if (L >= 32) return false; u.g = L >> 3; u.pm = L & 7; u.pn = 0; return true; }
    __device__ __forceinline__ void a_ready(const Unit&) const {}
    __device__ __forceinline__ void done(const Unit&) const {}
};


template <class Epi, class Sched, bool ALIGN_EPI = false, bool SP2 = false>
__device__ __forceinline__ void gemm_phase(PG8_LAS unsigned char* lds, const Gemm g, const Sched& S, const Epi& E) {
    int tid = threadIdx.x; asm volatile("" : "+v"(tid));   const int wid = __builtin_amdgcn_readfirstlane(tid >> 6), lane = tid & 63, wr = wid >> 2, wc = wid & 3, fr = lane & 15, fq = lane >> 4;
    int K = g.K; asm volatile("" : "+s"(K)); const int nt = K / BK;
    unsigned voffA[2], voffB[2];
#pragma unroll
    for (int i = 0; i < 2; ++i) { int R, C; stage_rc(tid * 16 + i * 8192, R, C); const int Rb = Epi::PERM ? ((R & ~31) + perm32(R & 31)) : R;
        voffA[i] = (unsigned)(R * g.lda + C) * 2u; voffB[i] = (unsigned)(Rb * g.ldb + C) * 2u; }
    const size_t kstep = (size_t)(BK * 2);
    const size_t hstepA = (size_t)HALF * g.lda * 2, hstepB = (size_t)HALF * g.ldb * 2;
    const size_t tstepA = 2 * hstepA, tstepB = 2 * hstepB;
    const unsigned ldsw = (unsigned)wid * 1024u;
    const int aoff = lds_byte(wr * 64 + fr, fq * 8), boff = lds_byte(wc * 32 + fr, fq * 8);
#define PG8_SA(b, h) (((b) * 2 + (h)) * HTB)
#define PG8_SB(b, h) ((4 + (b) * 2 + (h)) * HTB)
#define PG8_STAGE(bufoff, gbase, voff) do { _Pragma("unroll") for (int _i = 0; _i < 2; ++_i) \
        __builtin_amdgcn_global_load_lds((const unsigned*)((const char*)(gbase) + (voff)[_i]), (PG8_LAS unsigned*)(lds + (bufoff) + ldsw + _i * 8192), 16, 0, 0); } while (0)
#define PG8_LDA(dst, b, h) do { _Pragma("unroll") for (int m = 0; m < 4; ++m) _Pragma("unroll") for (int k = 0; k < 2; ++k) dst[m][k] = *(const PG8_LAS bf16x8*)(lds + PG8_SA(b, h) + aoff + m * 2048 + k * 1024); } while (0)
#define PG8_LDB(dst, b, h) do { _Pragma("unroll") for (int n = 0; n < 2; ++n) _Pragma("unroll") for (int k = 0; k < 2; ++k) dst[n][k] = *(const PG8_LAS bf16x8*)(lds + PG8_SB(b, h) + boff + n * 2048 + k * 1024); } while (0)
#define PG8_MMA(ai, bj, At, Bt) do { __builtin_amdgcn_s_setprio(1); _Pragma("unroll") for (int m = 0; m < 4; ++m) _Pragma("unroll") for (int n = 0; n < 2; ++n) _Pragma("unroll") for (int k = 0; k < 2; ++k) \
        acc[ai][bj][m][n] = __builtin_amdgcn_mfma_f32_16x16x32_bf16(Bt[n][k], At[m][k], acc[ai][bj][m][n], 0, 0, 0); __builtin_amdgcn_s_setprio(0); } while (0)
#define PG8_WAIT_V(n) asm volatile("s_waitcnt vmcnt(" #n ")" ::: "memory")
#define PG8_WAIT_L(n) asm volatile("s_waitcnt lgkmcnt(" #n ")" ::: "memory")
#define PG8_BAR __builtin_amdgcn_s_barrier()
#define PG8_SCHED __builtin_amdgcn_sched_barrier(0)
    Unit cur, nxt; int ui = 0;
    if (!S.next(0, cur)) return;
    f32x4 acc[2][2][4][2];
#pragma unroll
    for (int a = 0; a < 2; ++a)
#pragma unroll
        for (int b = 0; b < 2; ++b)
#pragma unroll
            for (int m = 0; m < 4; ++m)
#pragma unroll
                for (int n = 0; n < 2; ++n) acc[a][b][m][n] = (f32x4){0.f, 0.f, 0.f, 0.f};
    bf16x8 At[4][2], B0[2][2], B1[2][2];
    const char* cA = (const char*)(g.A + (size_t)cur.g * g.gsA) + (size_t)cur.pm * tstepA; const char* cB = (const char*)(g.Bt + (size_t)cur.g * g.gsB) + (size_t)cur.pn * tstepB;
    S.a_ready(cur);
    if constexpr (SP2) {
        PG8_STAGE(PG8_SB(0, 0), cB, voffB); PG8_STAGE(PG8_SB(0, 1), cB + hstepB, voffB); PG8_STAGE(PG8_SA(0, 0), cA, voffA); PG8_STAGE(PG8_SA(0, 1), cA + hstepA, voffA);
        if (wr == 1) PG8_BAR;
        PG8_WAIT_V(2); PG8_BAR;
        PG8_STAGE(PG8_SB(1, 0), cB + kstep, voffB); PG8_STAGE(PG8_SA(1, 0), cA + kstep, voffA); PG8_STAGE(PG8_SB(1, 1), cB + hstepB + kstep, voffB);
        PG8_WAIT_V(6); PG8_BAR;
    } else {
        PG8_STAGE(PG8_SB(0, 0), cB, voffB); PG8_STAGE(PG8_SA(0, 0), cA, voffA); PG8_STAGE(PG8_SB(0, 1), cB + hstepB, voffB); PG8_STAGE(PG8_SA(0, 1), cA + hstepA, voffA);
        if (wr == 1) PG8_BAR;
        PG8_WAIT_V(4); PG8_BAR;
        PG8_STAGE(PG8_SB(1, 0), cB + kstep, voffB); PG8_STAGE(PG8_SA(1, 0), cA + kstep, voffA); PG8_STAGE(PG8_SB(1, 1), cB + hstepB + kstep, voffB);
        PG8_WAIT_V(6); PG8_BAR;
    }
    for (;;) {
        const bool has_next = S.next(ui + 1, nxt);
        const char* nA = has_next ? (const char*)(g.A + (size_t)nxt.g * g.gsA) + (size_t)nxt.pm * tstepA : cA; const char* nB = has_next ? (const char*)(g.Bt + (size_t)nxt.g * g.gsB) + (size_t)nxt.pn * tstepB : cB;
        for (int t = 0; t < nt; t += 2) {
            if constexpr (Epi::MIDK) { if (t == (nt >> 1)) { asm volatile("s_waitcnt vmcnt(0)" ::: "memory"); E.mid(acc, cur, wr, wc, fr, fq); asm volatile("s_waitcnt vmcnt(0)" ::: "memory"); } }
            const bool last = (t == nt - 2);
            const char* a1 = cA + (size_t)(t + 1) * kstep;
            const char* a2 = last ? nA : cA + (size_t)(t + 2) * kstep; const char* b2 = last ? nB : cB + (size_t)(t + 2) * kstep;
            const char* a3 = a2 + kstep; const char* b3 = b2 + kstep;
            if (last && has_next) S.a_ready(nxt);
            if constexpr (SP2) {
            PG8_LDB(B0, 0, 0); PG8_LDB(B1, 0, 1); PG8_SCHED; PG8_LDA(At, 0, 0); PG8_STAGE(PG8_SA(1, 1), a1 + hstepA, voffA);
            PG8_WAIT_V(8); PG8_WAIT_L(0); PG8_BAR; PG8_MMA(0, 0, At, B0); PG8_MMA(0, 1, At, B1); PG8_BAR; PG8_SCHED;
            PG8_LDA(At, 0, 1); PG8_STAGE(PG8_SB(0, 0), b2, voffB); PG8_STAGE(PG8_SB(0, 1), b2 + hstepB, voffB); PG8_STAGE(PG8_SA(0, 0), a2, voffA);
            PG8_WAIT_V(8); PG8_WAIT_L(0); PG8_BAR; PG8_MMA(1, 0, At, B0); PG8_MMA(1, 1, At, B1); PG8_BAR; PG8_SCHED;
            PG8_LDB(B0, 1, 0); PG8_LDB(B1, 1, 1); PG8_SCHED; PG8_LDA(At, 1, 0); PG8_STAGE(PG8_SA(0, 1), a2 + hstepA, voffA);
            PG8_WAIT_V(8); PG8_WAIT_L(0); PG8_BAR; PG8_MMA(0, 0, At, B0); PG8_MMA(0, 1, At, B1); PG8_BAR; PG8_SCHED;
            PG8_LDA(At, 1, 1); PG8_STAGE(PG8_SB(1, 0), b3, voffB); PG8_STAGE(PG8_SB(1, 1), b3 + hstepB, voffB); PG8_STAGE(PG8_SA(1, 0), a3, voffA);
            PG8_WAIT_V(8); PG8_WAIT_L(0); PG8_BAR; PG8_MMA(1, 0, At, B0); PG8_MMA(1, 1, At, B1); PG8_BAR; PG8_SCHED;
            } else {
            PG8_LDB(B0, 0, 0); PG8_SCHED; PG8_LDA(At, 0, 0); PG8_STAGE(PG8_SA(1, 1), a1 + hstepA, voffA);
            PG8_WAIT_L(8); PG8_BAR; PG8_WAIT_L(0); PG8_MMA(0, 0, At, B0); PG8_BAR; PG8_SCHED;
            PG8_LDB(B1, 0, 1); PG8_STAGE(PG8_SB(0, 0), b2, voffB);
            PG8_BAR; PG8_WAIT_L(0); PG8_MMA(0, 1, At, B1); PG8_BAR;
            PG8_LDA(At, 0, 1); PG8_STAGE(PG8_SA(0, 0), a2, voffA);
            PG8_BAR; PG8_WAIT_L(0); PG8_MMA(1, 0, At, B0); PG8_BAR; PG8_SCHED;
            PG8_STAGE(PG8_SB(0, 1), b2 + hstepB, voffB);
            PG8_WAIT_V(6); PG8_BAR; PG8_MMA(1, 1, At, B1); PG8_BAR;
            PG8_LDB(B0, 1, 0); PG8_SCHED; PG8_LDA(At, 1, 0); PG8_STAGE(PG8_SA(0, 1), a2 + hstepA, voffA);
            PG8_WAIT_L(8); PG8_BAR; PG8_WAIT_L(0); PG8_MMA(0, 0, At, B0); PG8_BAR; PG8_SCHED;
            PG8_LDB(B1, 1, 1); PG8_STAGE(PG8_SB(1, 0), b3, voffB);
            PG8_BAR; PG8_WAIT_L(0); PG8_MMA(0, 1, At, B1); PG8_BAR;
            PG8_LDA(At, 1, 1); PG8_STAGE(PG8_SA(1, 0), a3, voffA);
            PG8_BAR; PG8_WAIT_L(0); PG8_MMA(1, 0, At, B0); PG8_BAR; PG8_SCHED;
            PG8_STAGE(PG8_SB(1, 1), b3 + hstepB, voffB);
            PG8_WAIT_V(6); PG8_BAR; PG8_MMA(1, 1, At, B1); PG8_BAR;
            }
        }
        if constexpr (ALIGN_EPI) { if (wr == 0) PG8_BAR; }
        if constexpr (!Epi::AFTER_DRAIN) { E(acc, cur, wr, wc, fr, fq); S.done(cur); }
        if (!has_next) break;
#pragma unroll
        for (int a = 0; a < 2; ++a)
#pragma unroll
            for (int b = 0; b < 2; ++b)
#pragma unroll
                for (int m = 0; m < 4; ++m)
#pragma unroll
                    for (int n = 0; n < 2; ++n) acc[a][b][m][n] = (f32x4){0.f, 0.f, 0.f, 0.f};
        cur = nxt; cA = nA; cB = nB; ++ui;
        if constexpr (ALIGN_EPI) { if (wr == 1) PG8_BAR; }
    }
    PG8_WAIT_V(0);
    if constexpr (!ALIGN_EPI) { if (wr == 0) PG8_BAR; }
    PG8_BAR;
    if constexpr (Epi::AFTER_DRAIN) { E.fused(acc, cur, wr, wc, fr, fq, lds, wid, lane); S.done(cur); }
#undef PG8_SA
#undef PG8_SB
#undef PG8_STAGE
#undef PG8_LDA
#undef PG8_LDB
#undef PG8_MMA
#undef PG8_WAIT_V
#undef PG8_WAIT_L
#undef PG8_BAR
#undef PG8_SCHED
}
}
#include <hip/hip_bf16.h>
#include <cmath>
namespace attn_body {
using bf16=__hip_bfloat16;
using bf16x8=__attribute__((ext_vector_type(8)))short;
using s16x4=__attribute__((ext_vector_type(4)))short;
using f32x16=__attribute__((ext_vector_type(16)))float;
using u32x4=__attribute__((ext_vector_type(4)))unsigned;
constexpr int BATCH=1,NHEAD=16,SEQ=8192,D=64,DM=NHEAD*D;
constexpr int NW=8,QBLK=32,QB=QBLK*NW,KVBLK=64,NQB=SEQ/QB;
constexpr int ATTN_PITCH=DM, ATTN_UNIT_ROWS=QB;
__device__ __forceinline__ int crow(int r,int hi){return (r&3)+8*(r>>2)+4*hi;}
#define SBAR() __builtin_amdgcn_sched_barrier(0)
__device__ __forceinline__ void cmask(f32x16&p0,f32x16&p1,int jb,int qrel,int hi){
  const float NEG=-INFINITY; int kb=64*jb+4*hi;
  #pragma unroll
  for(int r=0;r<16;++r){int kv=kb+(r&3)+8*(r>>2); if(kv>qrel)p0[r]=NEG; if(kv+32>qrel)p1[r]=NEG;}
}

constexpr int NSLOT=3, SLOTB=8192;
constexpr int LDS_K=0, LDS_V=NSLOT*SLOTB, LDS_WS=3*NSLOT*SLOTB  , LDS_OST=LDS_WS+NW*64*4, LDS_BYTES=LDS_OST+NW*4096;
constexpr float C2=0.125f*1.4426950408889634f;
__device__ __forceinline__ void glds16(const void*gsrc,unsigned lds_dst){unsigned keep;
  asm volatile("s_mov_b32 %0, m0\n\ts_mov_b32 m0, %2\n\ts_nop 0\n\tglobal_load_lds_dwordx4 %1, off\n\ts_mov_b32 m0, %0":"=&s"(keep):"v"(gsrc),"s"(lds_dst):"memory");}
__device__ __forceinline__ float max3f(float a,float b,float c){float r;asm("v_max3_f32 %0, %1, %2, %3":"=v"(r):"v"(a),"v"(b),"v"(c));return r;}
__device__ __forceinline__ float max2f(float a,float b){float r;asm("v_max_f32_e32 %0, %1, %2":"=v"(r):"v"(a),"v"(b));return r;}
__device__ __forceinline__ float fadd_s(float a,float b){float r;asm("v_add_f32_e32 %0, %1, %2":"=v"(r):"v"(a),"v"(b));return r;}
__device__ __forceinline__ float fsub_s(float a,float b){float r;asm("v_sub_f32_e32 %0, %1, %2":"=v"(r):"v"(a),"v"(b));return r;}
typedef float f32x2_t __attribute__((ext_vector_type(2))); typedef __bf16 bf16x2_t __attribute__((ext_vector_type(2)));
__device__ __forceinline__ unsigned cvtpk_s(float lo,float hi){f32x2_t v={lo,hi};bf16x2_t b=__builtin_convertvector(v,bf16x2_t);return __builtin_bit_cast(unsigned,b);}
#define WAIT_BAR(N) asm volatile("s_waitcnt vmcnt(" #N ") lgkmcnt(0)\n\ts_barrier":::"memory")

__device__ __forceinline__ void qkt(f32x16&p0,f32x16&p1,const char*Kslot,const bf16x8*qr,const f32x16&negm,int r32,int hi){
  const char*kb=Kslot+hi*1024+r32*16;
  #pragma unroll
  for(int d0=0;d0<4;++d0){
    const bf16x8 b0=*reinterpret_cast<const bf16x8*>(kb+d0*2048);
    const bf16x8 b1=*reinterpret_cast<const bf16x8*>(kb+d0*2048+512);
    if(d0==0){p0=__builtin_amdgcn_mfma_f32_32x32x16_bf16(b0,qr[0],negm,0,0,0);p1=__builtin_amdgcn_mfma_f32_32x32x16_bf16(b1,qr[0],negm,0,0,0);}
    else{p0=__builtin_amdgcn_mfma_f32_32x32x16_bf16(b0,qr[d0],p0,0,0,0);p1=__builtin_amdgcn_mfma_f32_32x32x16_bf16(b1,qr[d0],p1,0,0,0);}}
}
typedef __attribute__((address_space(3))) const char* lds_cptr;
typedef short v4i16_t __attribute__((ext_vector_type(4)));
__device__ __forceinline__ void kload8(bf16x8*kf,lds_cptr kp){
  kf[0]=*(const __attribute__((address_space(3))) bf16x8*)(kp);      kf[1]=*(const __attribute__((address_space(3))) bf16x8*)(kp+512);
  kf[2]=*(const __attribute__((address_space(3))) bf16x8*)(kp+2048); kf[3]=*(const __attribute__((address_space(3))) bf16x8*)(kp+2560);
  kf[4]=*(const __attribute__((address_space(3))) bf16x8*)(kp+4096); kf[5]=*(const __attribute__((address_space(3))) bf16x8*)(kp+4608);
  kf[6]=*(const __attribute__((address_space(3))) bf16x8*)(kp+6144); kf[7]=*(const __attribute__((address_space(3))) bf16x8*)(kp+6656);
}
__device__ __forceinline__ void kload2(bf16x8*kf,lds_cptr kp,int j){ kf[2*j]=*(const __attribute__((address_space(3))) bf16x8*)(kp+j*2048); kf[2*j+1]=*(const __attribute__((address_space(3))) bf16x8*)(kp+j*2048+512); }
__device__ __forceinline__ s16x4 vtr(lds_cptr p){ return __builtin_bit_cast(s16x4,__builtin_amdgcn_ds_read_tr16_b64_v4i16((__attribute__((address_space(3))) v4i16_t*)p)); }
__device__ __forceinline__ float rowmax(const f32x16&p0,const f32x16&p1){
  float a=max3f(p0[0],p0[1],p1[0]),b=max3f(p0[2],p0[3],p1[1]);a=max3f(a,p1[2],p1[3]);
  #pragma unroll
  for(int r=4;r<16;r+=4){a=max3f(a,p0[r],p0[r+1]);b=max3f(b,p0[r+2],p0[r+3]);a=max3f(a,p1[r],p1[r+1]);b=max3f(b,p1[r+2],p1[r+3]);}
  const float m=max2f(a,b);
  auto rr=__builtin_amdgcn_permlane32_swap(__float_as_uint(m),__float_as_uint(m),false,false);
  return max2f(__uint_as_float(rr[0]),__uint_as_float(rr[1]));
}
__device__ __forceinline__ void pv(f32x16*o,int vb,bf16x8 pa0,bf16x8 pa1,bf16x8 pa2,bf16x8 pa3){
  #pragma unroll
  for(int d0=0;d0<2;++d0){s16x4 lo[4],hi[4];
    #pragma unroll
    for(int ks=0;ks<4;++ks){
      asm volatile("ds_read_b64_tr_b16 %0,%1 offset:%c2":"=&v"(lo[ks]):"v"(vb),"i"(d0*4096+ks*1024):"memory");
      asm volatile("ds_read_b64_tr_b16 %0,%1 offset:%c2":"=&v"(hi[ks]):"v"(vb),"i"(d0*4096+ks*1024+512):"memory");}
    asm volatile("s_waitcnt lgkmcnt(0)":::"memory");SBAR();
    #define PK(k) (bf16x8){lo[k][0],lo[k][1],lo[k][2],lo[k][3],hi[k][0],hi[k][1],hi[k][2],hi[k][3]}
    o[d0]=__builtin_amdgcn_mfma_f32_32x32x16_bf16(pa0,PK(0),o[d0],0,0,0);
    o[d0]=__builtin_amdgcn_mfma_f32_32x32x16_bf16(pa1,PK(1),o[d0],0,0,0);
    o[d0]=__builtin_amdgcn_mfma_f32_32x32x16_bf16(pa2,PK(2),o[d0],0,0,0);
    o[d0]=__builtin_amdgcn_mfma_f32_32x32x16_bf16(pa3,PK(3),o[d0],0,0,0);
    #undef PK
  }
}

#ifndef ATTN_STORE16
#define ATTN_STORE16(p,v) (*(u32x4*)(p)=(v))
#endif
template<int THRL> __device__ __forceinline__ void attn_unit(int hq,int hv,int qb,const bf16*Q,const bf16*__restrict__ K,const bf16*__restrict__ V,bf16*O,const float slope2,const int t0,const int ntiles,const bool band,float*Lout,const float bref,char*shm){
  int tid=threadIdx.x; asm volatile("":"+v"(tid)); const int lane=tid&63,r32=lane&31,hi=lane>>5; const int wid=__builtin_amdgcn_readfirstlane(tid>>6);
  const long rowbase=0; const int q0=qb*QB;
  const bf16*Qw=Q+(rowbase+q0+wid*QBLK)*DM+hq*D;
  const bf16*Kh=K+(rowbase+(long)t0*KVBLK)*DM+hq*D,*Vh=V+(rowbase+(long)t0*KVBLK)*DM+hv*D;
  const unsigned lds0=(unsigned)(uintptr_t)shm;
  float*wsf=(float*)(shm+LDS_WS)+wid*64;
  const bf16*ksrc=Kh+(long)lane*DM+wid*8;
  const bf16*vsrc=Vh+(long)(16*(wid&3)+(lane>>2))*DM+(wid>>2)*32+(lane&3)*8;
  const unsigned kdst=lds0+LDS_K+wid*1024, vdst=lds0+LDS_V+wid*1024;
  #define DMA_K(t,slot) glds16(ksrc+(long)(t)*KVBLK*DM,(unsigned)__builtin_amdgcn_readfirstlane(kdst+(slot)))
  #define DMA_V(t,slot) do{ glds16(vsrc+(long)(t)*KVBLK*DM,(unsigned)__builtin_amdgcn_readfirstlane(vdst+2*(slot))); glds16(vsrc+64+(long)(t)*KVBLK*DM,(unsigned)__builtin_amdgcn_readfirstlane(vdst+2*(slot)+8192)); }while(0)
  const int vb0=(int)(lds0+LDS_V)+((lane>>4)&1)*32+(lane&3)*8+(4*hi+((lane&15)>>2))*64;
  const char*Kbase=shm+LDS_K; bf16x8 kf[8];
  const lds_cptr shm3=(lds_cptr)shm; const lds_cptr kp0=shm3+LDS_K+hi*1024+r32*16; const lds_cptr vp0=shm3+LDS_V+((lane>>4)&1)*32+(lane&3)*8+(4*hi+((lane&15)>>2))*64;
  const int NT=ntiles;
  DMA_K(0,0);DMA_V(0,0);DMA_K(1,SLOTB);
  bf16x8 qr[4];
  #pragma unroll
  for(int d0=0;d0<4;++d0)qr[d0]=*reinterpret_cast<const bf16x8*>(&Qw[(long)r32*DM+d0*16+hi*8]);
  const int qrel=wid*QBLK+r32;
  const float dstep=64.f*slope2; const float abase=slope2*(float)(64*t0+4*hi-(q0+qrel))-bref;
  float l_reg=0.f;f32x16 o[4];o[0]=f32x16{};o[1]=f32x16{};o[2]=f32x16{};o[3]=f32x16{};const f32x16 negm=f32x16{};
  #define CMASK(P0,P1,t) do{int jb_=(t)-(NT-4); if(band&&jb_>=0)cmask(P0,P1,jb_,qrel,hi);}while(0)
  bool resc=false;
  #define START(P0,P1) do{ resc=false; \
    { const float nm_=abase; \
      _Pragma("unroll") for(int r=0;r<16;++r){ const float kc_=(float)((r&3)+8*(r>>2)); P0[r]=__builtin_fmaf(slope2,kc_,P0[r]+nm_); P1[r]=__builtin_fmaf(slope2,kc_+32.f,P1[r]+nm_); } } \
    _Pragma("unroll") for(int r=0;r<16;++r)P0[r]=__builtin_amdgcn_exp2f(P0[r]); }while(0)
  #define RESC() do{ if(resc){ asm volatile("s_waitcnt lgkmcnt(0)":::"memory"); \
      _Pragma("unroll") for(int d_=0;d_<2;++d_) _Pragma("unroll") for(int r=0;r<16;++r)o[d_][r]*=wsf[crow(r,hi)]; } }while(0)
  f32x16 pA0,pA1,pB0,pB1;
  int sl_prev=0,sl_cur=0,sl_next=SLOTB;
  #define ROT() do{sl_prev=sl_cur;sl_cur=sl_next;sl_next=(sl_next==(NSLOT-1)*SLOTB)?0:sl_next+SLOTB;}while(0)
  DMA_K(2,2*SLOTB);
  WAIT_BAR(4);
  qkt(pA0,pA1,Kbase,qr,negm,r32,hi);asm volatile("s_nop 15\n\ts_nop 7":"+v"(pA0),"+v"(pA1));CMASK(pA0,pA1,0);
  START(pA0,pA1);
  _Pragma("unroll") for(int r=0;r<16;++r)pA1[r]=__builtin_amdgcn_exp2f(pA1[r]);
  WAIT_BAR(0);
  DMA_K(3,0);DMA_V(1,SLOTB);
  ROT();
  kload8(kf,kp0+sl_cur);
  WAIT_BAR(3);
  s16x4 vlo[8],vhi[8]; u32x4 pw0,pw1,pw2,pw3;
  #define PKW(P,B) cvtpk_s(P[B],P[B+1])
  #define PAF(k) __builtin_bit_cast(bf16x8,pw##k)
  #define VFR(i) (bf16x8){vlo[i][0],vlo[i][1],vlo[i][2],vlo[i][3],vhi[i][0],vhi[i][1],vhi[i][2],vhi[i][3]}
  #define PIN(x) asm volatile("":"+v"(x))
  #define MX3(a,b,c) __builtin_fmaxf(__builtin_fmaxf((a),(b)),(c))
  #define GAPA(MF,A0,A1,A2,A3,W0,W1,PW) do{ MF; sacc+=A0; sacc+=A1; sacc+=A2; sacc+=A3; PIN(sacc); W0; W1; PIN(PW); SBAR(); }while(0)
  #define EX(v) __builtin_amdgcn_exp2f(v)
  #define BX(v,k) EX(__builtin_fmaf(slope2,(float)(k),(v)+nm2_))
  #define GAPB(MF,X,B,KO) do{ MF; X[B]=BX(X[B],2*(B)+(KO)); X[B+1]=BX(X[B+1],2*(B)+1+(KO)); X[B+2]=BX(X[B+2],2*(B)+2+(KO)); X[B+3]=BX(X[B+3],2*(B)+3+(KO)); PIN(X); SBAR(); }while(0)
  #define VRD(i) do{ vlo[i]=vtr(vp_+(((i)>>2)*4096+((i)&3)*1024)); vhi[i]=vtr(vp_+(((i)>>2)*4096+((i)&3)*1024+512)); }while(0)
  #define VRD2(i) do{ vlo[i]=vtr(vp_+(8192+((i)>>2)*4096+((i)&3)*1024)); vhi[i]=vtr(vp_+(8192+((i)>>2)*4096+((i)&3)*1024+512)); SBAR(); }while(0)
  #define KRD(G,j) do{ if(G){ kload2(kf,kp0+sl_next,j); SBAR(); } }while(0)
  #define STEP(C0,C1,P0,P1,t,GK,GV,GL) do{ SBAR(); \
    const lds_cptr vp_=vp0+2*sl_prev; \
    VRD(0); SBAR(); float sacc=(P0[0]+P0[1]); \
    GAPA(C0=__builtin_amdgcn_mfma_f32_32x32x16_bf16(kf[0],qr[0],negm,0,0,0), P0[2],P0[3],P0[4],P0[5],     pw0[0]=PKW(P0,0), pw0[1]=PKW(P0,2), pw0); \
    VRD(4); SBAR(); GAPA(C1=__builtin_amdgcn_mfma_f32_32x32x16_bf16(kf[1],qr[0],negm,0,0,0), P0[6],P0[7],P0[8],P0[9],     pw0[2]=PKW(P0,4), pw0[3]=PKW(P0,6), pw0); \
    VRD(1); SBAR(); GAPA(C0=__builtin_amdgcn_mfma_f32_32x32x16_bf16(kf[2],qr[1],C0,0,0,0),   P0[10],P0[11],P0[12],P0[13], pw1[0]=PKW(P0,8), pw1[1]=PKW(P0,10), pw1); \
    VRD(5); SBAR(); GAPA(C1=__builtin_amdgcn_mfma_f32_32x32x16_bf16(kf[3],qr[1],C1,0,0,0),   P0[14],P0[15],P1[0],P1[1],   pw1[2]=PKW(P0,12),pw1[3]=PKW(P0,14), pw1); \
    VRD(2); SBAR(); GAPA(C0=__builtin_amdgcn_mfma_f32_32x32x16_bf16(kf[4],qr[2],C0,0,0,0),   P1[2],P1[3],P1[4],P1[5],     pw2[0]=PKW(P1,0), pw2[1]=PKW(P1,2), pw2); \
    VRD(6); SBAR(); GAPA(C1=__builtin_amdgcn_mfma_f32_32x32x16_bf16(kf[5],qr[2],C1,0,0,0),   P1[6],P1[7],P1[8],P1[9],     pw2[2]=PKW(P1,4), pw2[3]=PKW(P1,6), pw2); \
    VRD(3); SBAR(); GAPA(C0=__builtin_amdgcn_mfma_f32_32x32x16_bf16(kf[6],qr[3],C0,0,0,0),   P1[10],P1[11],P1[12],P1[13], pw3[0]=PKW(P1,8), pw3[1]=PKW(P1,10), pw3); \
    VRD(7); SBAR(); GAPA(C1=__builtin_amdgcn_mfma_f32_32x32x16_bf16(kf[7],qr[3],C1,0,0,0),   P1[14],P1[15],0.f,0.f,       pw3[2]=PKW(P1,12),pw3[3]=PKW(P1,14), pw3); \
    l_reg+=sacc; \
    if(GK){DMA_K((t)+3,sl_cur);} if(GV){DMA_V((t)+1,sl_next);} \
    CMASK(C0,C1,t); \
    const float nm2_=__builtin_fmaf(dstep,(float)(t),abase); \
    SBAR(); \
    GAPB(o[0]=__builtin_amdgcn_mfma_f32_32x32x16_bf16(PAF(0),VFR(0),o[0],0,0,0), C0,0,0); VRD2(0); \
    GAPB(o[1]=__builtin_amdgcn_mfma_f32_32x32x16_bf16(PAF(0),VFR(4),o[1],0,0,0), C0,4,0); VRD2(4); \
    KRD(GL,0); GAPB(o[0]=__builtin_amdgcn_mfma_f32_32x32x16_bf16(PAF(1),VFR(1),o[0],0,0,0), C0,8,0); VRD2(1); \
    KRD(GL,1); GAPB(o[1]=__builtin_amdgcn_mfma_f32_32x32x16_bf16(PAF(1),VFR(5),o[1],0,0,0), C0,12,0); VRD2(5); \
    KRD(GL,2); GAPB(o[0]=__builtin_amdgcn_mfma_f32_32x32x16_bf16(PAF(2),VFR(2),o[0],0,0,0), C1,0,32); VRD2(2); \
    KRD(GL,3); GAPB(o[1]=__builtin_amdgcn_mfma_f32_32x32x16_bf16(PAF(2),VFR(6),o[1],0,0,0), C1,4,32); VRD2(6); \
    GAPB(o[0]=__builtin_amdgcn_mfma_f32_32x32x16_bf16(PAF(3),VFR(3),o[0],0,0,0), C1,8,32); VRD2(3); \
    GAPB(o[1]=__builtin_amdgcn_mfma_f32_32x32x16_bf16(PAF(3),VFR(7),o[1],0,0,0), C1,12,32); VRD2(7); \
    SBAR(); \
    o[2]=__builtin_amdgcn_mfma_f32_32x32x16_bf16(PAF(0),VFR(0),o[2],0,0,0); \
    o[3]=__builtin_amdgcn_mfma_f32_32x32x16_bf16(PAF(0),VFR(4),o[3],0,0,0); \
    o[2]=__builtin_amdgcn_mfma_f32_32x32x16_bf16(PAF(1),VFR(1),o[2],0,0,0); \
    o[3]=__builtin_amdgcn_mfma_f32_32x32x16_bf16(PAF(1),VFR(5),o[3],0,0,0); \
    o[2]=__builtin_amdgcn_mfma_f32_32x32x16_bf16(PAF(2),VFR(2),o[2],0,0,0); \
    o[3]=__builtin_amdgcn_mfma_f32_32x32x16_bf16(PAF(2),VFR(6),o[3],0,0,0); \
    o[2]=__builtin_amdgcn_mfma_f32_32x32x16_bf16(PAF(3),VFR(3),o[2],0,0,0); \
    o[3]=__builtin_amdgcn_mfma_f32_32x32x16_bf16(PAF(3),VFR(7),o[3],0,0,0); \
    SBAR(); \
    }while(0)
  int t=1;
  #undef CMASK
  #define CMASK(P0,P1,t) do{}while(0)
  for(;t+5<NT;t+=2){
    STEP(pB0,pB1,pA0,pA1,t,true,true,true);     WAIT_BAR(3); RESC(); ROT();
    STEP(pA0,pA1,pB0,pB1,t+1,true,true,true);   WAIT_BAR(3); RESC(); ROT();
  }
  #undef CMASK
  #define CMASK(P0,P1,t) do{int jb_=(t)-(NT-4); if(band&&jb_>=0)cmask(P0,P1,jb_,qrel,hi);}while(0)
  #define ENDW(tt) do{ if((tt)+3<NT){WAIT_BAR(3);} else if((tt)+2<NT){WAIT_BAR(2);} else {WAIT_BAR(0);} }while(0)
  for(;t+1<NT;t+=2){
    STEP(pB0,pB1,pA0,pA1,t,(t+3<NT),(t+1<NT),(t+1<NT));       ENDW(t);   RESC(); ROT();
    STEP(pA0,pA1,pB0,pB1,t+1,(t+4<NT),(t+2<NT),(t+2<NT));     ENDW(t+1); RESC(); ROT();
  }
  STEP(pB0,pB1,pA0,pA1,NT-1,false,false,false); RESC();
  { float sacc=pB0[0]+pB0[1]; _Pragma("unroll") for(int r=2;r<16;++r)sacc+=pB0[r]; _Pragma("unroll") for(int r=0;r<16;++r)sacc+=pB1[r]; l_reg+=sacc;
    pw0=(u32x4){PKW(pB0,0),PKW(pB0,2),PKW(pB0,4),PKW(pB0,6)};pw1=(u32x4){PKW(pB0,8),PKW(pB0,10),PKW(pB0,12),PKW(pB0,14)};pw2=(u32x4){PKW(pB1,0),PKW(pB1,2),PKW(pB1,4),PKW(pB1,6)};pw3=(u32x4){PKW(pB1,8),PKW(pB1,10),PKW(pB1,12),PKW(pB1,14)};
    SBAR(); pv(o,vb0+2*sl_cur,PAF(0),PAF(1),PAF(2),PAF(3)); pv(o+2,vb0+2*sl_cur+8192,PAF(0),PAF(1),PAF(2),PAF(3)); }
  #undef PKW
  #undef PAF
  #undef VFR
  #undef PIN
  #undef MX3
  #undef GAPA
  #undef GAPB
  #undef BX
  #undef EX
  #undef VRD
  #undef VRD2
  #undef KRD
  #undef STEP
  #undef ENDW
  {auto rr=__builtin_amdgcn_permlane32_swap(__float_as_uint(l_reg),__float_as_uint(l_reg),false,false);l_reg=__uint_as_float(rr[0])+__uint_as_float(rr[1]);}
  if(hi==0){wsf[32+r32]=l_reg; if(Lout)Lout[(long)(q0+qrel)*8]=l_reg;}asm volatile("s_waitcnt lgkmcnt(0)":::"memory");
  float rli[16];
  #pragma unroll
  for(int r=0;r<16;++r)rli[r]=__builtin_amdgcn_rcpf(wsf[32+crow(r,hi)]);
  bf16*Ow=O+(rowbase+q0+wid*QBLK)*DM+hv*D;
  { bf16*stg=(bf16*)(shm+LDS_OST)+wid*2048;
    #pragma unroll
    for(int hf=0;hf<2;++hf){
      #pragma unroll
      for(int r=0;r<16;++r){const int orow=crow(r,hi);
        #pragma unroll
        for(int d0=0;d0<2;++d0)stg[orow*64+d0*32+r32]=__float2bfloat16(o[2*hf+d0][r]*rli[r]);}
      asm volatile("s_waitcnt lgkmcnt(0)":::"memory");
      #pragma unroll
      for(int i=0;i<4;++i){const int row=i*8+(lane>>3),ch=lane&7; const u32x4 v=*(const u32x4*)(stg+row*64+ch*8); ATTN_STORE16(Ow+(long)row*DM+hf*64+ch*8,v);}
      asm volatile("s_waitcnt lgkmcnt(0)":::"memory"); } }
  asm volatile("s_waitcnt lgkmcnt(0)\n\ts_barrier":::"memory");
  #undef DMA_K
  #undef DMA_V
  #undef CMASK
  #undef START
  #undef RESC
  #undef ROT
}
constexpr int ATTN_LDS_BYTES=LDS_BYTES;
struct AttnTensors { const bf16* Q; const bf16* K; const bf16* V; bf16* O; bf16* O2; };
struct AttnUnit { int bh; int qb; };
struct StaticOrder {
  int vcu;
  __device__ __forceinline__ explicit StaticOrder(int grid,int block):vcu((block%8)*(grid/8)+block/8){}
  __device__ __forceinline__ bool next(int i,AttnUnit&u)const{ if(i>=4)return false; const int s=vcu&7; u.bh=vcu>>3; u.qb=(i==0)?s:(i==1)?15-s:(i==2)?16+s:31-s; return true; }
  __device__ __forceinline__ void a_ready(const AttnUnit&)const{}
  __device__ __forceinline__ void done(const AttnUnit&)const{}
};
template<class Sched,int THRL=8> __device__ __forceinline__ void attn_phase(char*lds,const AttnTensors&T,const Sched&S){
  AttnUnit u;
  for(int i=0;S.next(i,u);++i){ S.a_ready(u); { const int h_=u.bh>>2, c_=(u.bh>>1)&1, vh_=u.bh&1; attn_unit<THRL>(c_*8+h_, 2*h_+vh_, u.qb, T.Q, T.K, T.V, c_? T.O2 : T.O, __builtin_exp2f(-(float)(h_+1))*1.4426950408889634f, 0, 4*u.qb+4, true, nullptr, 64.f, lds); } S.done(u); }
}
#undef SBAR
#undef WAIT_BAR
}
#ifndef REP_P0
#define REP_P0 1
#endif
#ifndef REP_P1
#define REP_P1 1
#endif
#ifndef REP_P2
#define REP_P2 1
#endif
#ifndef REP_P3
#define REP_P3 1
#endif
#ifndef REP_G4
#define REP_G4 0
#endif
#ifndef REP_G6
#define REP_G6 0
#endif
#ifndef REP_P4
#define REP_P4 1
#endif
#ifndef REP_P5
#define REP_P5 1
#endif
constexpr int NWAVES = 8;
constexpr int S = 8192, DM = 2048, INW = 8192, FF = 8192, PLE = 256, ATTW = 1024;
constexpr float NORM_EPS = 1e-6f;
constexpr float LAM_INIT = 0.2f;
constexpr float QSCALE = 0.125f * 1.4426950408889634f;
constexpr size_t MiB = 1u << 20;
constexpr size_t WS_BAR = 1u << 20;
constexpr size_t WS_FLAGS = (1u << 20) + 65536;
constexpr size_t WS_SS = 0;
constexpr size_t WS_WIN = 2 * MiB, WS_WUP = 34 * MiB, WS_WDN = 66 * MiB, WS_WOUT = 98 * MiB, WS_WPG = 106 * MiB, WS_WPB = 114 * MiB, WS_WBR = 118 * MiB  , WS_WPLE = 126 * MiB, WS_PGW = 127 * MiB;
constexpr size_t WS_PB = 128 * MiB;
constexpr size_t WS_HN = 132 * MiB;
constexpr size_t WS_Z = 164 * MiB;
constexpr size_t WS_G = 228 * MiB;
constexpr size_t WS_AB2 = 132 * MiB;
constexpr size_t WS_SCR = 292 * MiB;
constexpr size_t WS_MG = 164 * MiB;
constexpr size_t WS_XB = 260 * MiB;
constexpr size_t WS_H = 132 * MiB;
constexpr size_t WS_PE = 132 * MiB;
constexpr size_t WS_END = 308 * MiB;
constexpr int LDS_BYTES = 131072 + 1024;
constexpr int ATT_SPLIT_MIN = 16;

#define GAS __attribute__((address_space(1)))
#define LAS __attribute__((address_space(3)))
typedef unsigned short bfu;
typedef unsigned v4u __attribute__((ext_vector_type(4)));
typedef float f32x4 __attribute__((ext_vector_type(4)));
#define LDS_WAIT() asm volatile("s_waitcnt lgkmcnt(0)" ::: "memory")
__device__ __forceinline__ unsigned f2bf(float f) { unsigned u = __builtin_bit_cast(unsigned, f); return (u + 0x7fffu + ((u >> 16) & 1u)) >> 16; }
__device__ __forceinline__ unsigned pk2(float lo, float hi) { return f2bf(lo) | (f2bf(hi) << 16); }
__device__ __forceinline__ float wave_sum(float v) {
#pragma unroll
    for (int o = 1; o < 64; o <<= 1) v += __shfl_xor(v, o);
    return v;
}
__device__ __forceinline__ void p0_transpose_item(const float* W, int K, int N, bfu* WT, const float* gain, LAS float*  , int item, int lane, int ldk = 0) {
    if (ldk == 0) ldk = K;
    const int nblk = N / 32, kb = item / nblk, nb = item % nblk, k0 = 64 * kb, n0 = 32 * nb, kg = lane >> 3, n4 = lane & 7;
    const float* src = W + (size_t)(k0 + 8 * kg) * N + n0 + 4 * n4;
    f32x4 v[8];
#pragma unroll
    for (int j = 0; j < 8; ++j) v[j] = __builtin_nontemporal_load((const f32x4*)(src + (size_t)j * N));
    if (gain) { const f32x4 g0 = *(const f32x4*)(gain + k0 + 8 * kg), g1 = *(const f32x4*)(gain + k0 + 8 * kg + 4);
#pragma unroll
        for (int j = 0; j < 4; ++j) { v[j] = v[j] * g0[j]; v[4 + j] = v[4 + j] * g1[j]; } }
    bfu* dst = WT + (size_t)(n0 + 4 * n4) * ldk + k0 + 8 * kg;
#pragma unroll
    for (int i = 0; i < 4; ++i) { v4u o; o.x = pk2(v[0][i], v[1][i]); o.y = pk2(v[2][i], v[3][i]); o.z = pk2(v[4][i], v[5][i]); o.w = pk2(v[6][i], v[7][i]); *(v4u*)(dst + (size_t)i * ldk) = o; }
}
#define XB_TMO      128
#define XB_XCNT(j)  (256  + 64 * (j))
#define XB_XSUB(j)  (1280 + 64 * (j))
#define XB_XGEN(j)  (2304 + 64 * (j))
#define XB_TOP      3328
#define XB_TOPGEN   3392
#define XCD_BAR_WORDS 3456
#define XB_SPIN_CAP (1u << 18)

__device__ __forceinline__ unsigned xb_ld(unsigned* p)              { return __hip_atomic_load(p, __ATOMIC_RELAXED, __HIP_MEMORY_SCOPE_AGENT); }
__device__ __forceinline__ unsigned xb_add(unsigned* p, unsigned v) { return __hip_atomic_fetch_add(p, v, __ATOMIC_RELAXED, __HIP_MEMORY_SCOPE_AGENT); }
__device__ __forceinline__ unsigned xb_xcc_id() { return (unsigned)__builtin_amdgcn_s_getreg((3 << 11) | 20) & 0xFu; }
#define XB_SPIN(cond, bar) do { unsigned _sp = 0; while (cond) { __builtin_amdgcn_s_sleep(1); \
    if ((++_sp & 255u) == 0u) { if (xb_ld(&(bar)[XB_TMO])) break; if (_sp > XB_SPIN_CAP) { atomicAdd(&(bar)[XB_TMO], 1u); break; } } } } while (0)

struct XcdBarrier {
    unsigned* bar; unsigned x;
    volatile LAS unsigned* st;
};

__device__ __forceinline__ XcdBarrier xcd_barrier_post(unsigned* bar, volatile LAS unsigned* st) {
    XcdBarrier b; b.bar = bar; b.x = xb_xcc_id(); b.st = st;
    if (threadIdx.x == 0) (void)xb_add(&bar[XB_XCNT(b.x)], 1u);
    return b;
}
__device__ __forceinline__ void xcd_barrier_complete(unsigned* bar, unsigned x, unsigned& nloc, unsigned& nx) {
    const unsigned G = gridDim.x * gridDim.y * gridDim.z;
    unsigned sum, cnt, mine, sp = 0u;
    for (;;) {
        sum = 0u; cnt = 0u; mine = 0u;
#pragma unroll
        for (unsigned j = 0; j < 16; ++j) { const unsigned c = xb_ld(&bar[XB_XCNT(j)]); sum += c; cnt += (c > 0u) ? 1u : 0u; mine = (j == x) ? c : mine; }
        if (sum == G) break;
        __builtin_amdgcn_s_sleep(1);
        if ((++sp & 255u) == 0u) { if (xb_ld(&bar[XB_TMO])) break; if (sp > XB_SPIN_CAP) { atomicAdd(&bar[XB_TMO], 1u); break; } }
    }
    nloc = mine > 0u ? mine : 1u; nx = cnt > 0u ? cnt : 1u;
}

__device__ __forceinline__ void xcd_barrier(const XcdBarrier& b) {
    asm volatile("s_waitcnt vmcnt(0)" ::: "memory");
    __syncthreads();
    if (threadIdx.x == 0) {
        unsigned* bar = b.bar;
        __builtin_amdgcn_s_waitcnt(0);
        unsigned nloc = b.st[0], nx = b.st[1];
        if (nloc == 0u) { xcd_barrier_complete(bar, b.x, nloc, nx); b.st[0] = nloc; b.st[1] = nx; }
        const unsigned old = xb_add(&bar[XB_XSUB(b.x)], 1u);
        const unsigned gen = old / nloc;
        if (old + 1u == (gen + 1u) * nloc) {
            __builtin_amdgcn_fence(__ATOMIC_RELEASE, "agent");
            asm volatile("s_waitcnt vmcnt(0)" ::: "memory");
            const unsigned og = xb_add(&bar[XB_TOP], 1u);
            const unsigned tg = og / nx;
            if (og + 1u == (tg + 1u) * nx) xb_add(&bar[XB_TOPGEN], 1u);
            else XB_SPIN(xb_ld(&bar[XB_TOPGEN]) == tg, bar);
            __builtin_amdgcn_fence(__ATOMIC_ACQUIRE, "agent");
            xb_add(&bar[XB_XGEN(b.x)], 1u);
            asm volatile("s_waitcnt vmcnt(0)" ::: "memory");
        } else {
            XB_SPIN(xb_ld(&bar[XB_XGEN(b.x)]) == gen, bar);
            __builtin_amdgcn_fence(__ATOMIC_ACQUIRE, "agent");
            asm volatile("s_waitcnt vmcnt(0)" ::: "memory");
        }
    }
    __syncthreads();
}

constexpr unsigned long long FLAG_TOKEN = 0x5EA70B0A7C0FFEE1ull, FLAG_CLOSED = 0xC105EDC105EDC105ull;
__device__ __forceinline__ void flag_barrier(unsigned long long* slots, unsigned G, unsigned me) {
    asm volatile("s_waitcnt vmcnt(0)" ::: "memory");
    __syncthreads();
    if (threadIdx.x < 64) {
        if (threadIdx.x == 0) { __builtin_amdgcn_fence(__ATOMIC_RELEASE, "agent"); asm volatile("s_waitcnt vmcnt(0)" ::: "memory");
            __hip_atomic_store(slots + me, FLAG_TOKEN, __ATOMIC_RELAXED, __HIP_MEMORY_SCOPE_AGENT); }
        unsigned sp = 0;
        for (;;) { bool ok = true;
            for (unsigned i = threadIdx.x; i < G; i += 64) ok = ok && (__hip_atomic_load(slots + i, __ATOMIC_RELAXED, __HIP_MEMORY_SCOPE_AGENT) == FLAG_TOKEN);
            if (__all(ok)) break;
            __builtin_amdgcn_s_sleep(2); if (++sp > (1u << 20)) break; }
        __builtin_amdgcn_fence(__ATOMIC_ACQUIRE, "agent"); asm volatile("s_waitcnt vmcnt(0)" ::: "memory");
    }
    __syncthreads();
}
template <int W> __device__ __forceinline__ void pool_item(const bfu* u, bfu* pooled, int tb) {
    v4u r[W + 7];
#pragma unroll
    for (int j = 0; j < W + 7; ++j) { const int t = tb - (W - 1) + j; r[j] = (t >= 0) ? *(const v4u*)(u + (size_t)t * 1024) : (v4u){0u, 0u, 0u, 0u}; }
    float a[8];
#pragma unroll
    for (int e = 0; e < 8; ++e) a[e] = 0.f;
#pragma unroll
    for (int j = 0; j < W - 1; ++j) { a[0] += pg8::bf_lo(r[j].x); a[1] += pg8::bf_hi(r[j].x); a[2] += pg8::bf_lo(r[j].y); a[3] += pg8::bf_hi(r[j].y); a[4] += pg8::bf_lo(r[j].z); a[5] += pg8::bf_hi(r[j].z); a[6] += pg8::bf_lo(r[j].w); a[7] += pg8::bf_hi(r[j].w); }
#pragma unroll
    for (int k = 0; k < 8; ++k) {
        const v4u c = r[W - 1 + k]; const int t = tb + k;
        const float cv[8] = {pg8::bf_lo(c.x), pg8::bf_hi(c.x), pg8::bf_lo(c.y), pg8::bf_hi(c.y), pg8::bf_lo(c.z), pg8::bf_hi(c.z), pg8::bf_lo(c.w), pg8::bf_hi(c.w)};
#pragma unroll
        for (int e = 0; e < 8; ++e) a[e] += cv[e];
        const float inv = 1.f / (float)((t + 1) < W ? (t + 1) : W);
        v4u o; o.x = pk2(a[0] * inv - cv[0], a[1] * inv - cv[1]); o.y = pk2(a[2] * inv - cv[2], a[3] * inv - cv[3]); o.z = pk2(a[4] * inv - cv[4], a[5] * inv - cv[5]); o.w = pk2(a[6] * inv - cv[6], a[7] * inv - cv[7]);
        *(v4u*)(pooled + (size_t)t * 2048) = o;
        const v4u d = r[k];
        a[0] -= pg8::bf_lo(d.x); a[1] -= pg8::bf_hi(d.x); a[2] -= pg8::bf_lo(d.y); a[3] -= pg8::bf_hi(d.y); a[4] -= pg8::bf_lo(d.z); a[5] -= pg8::bf_hi(d.z); a[6] -= pg8::bf_lo(d.w); a[7] -= pg8::bf_hi(d.w);
    }
}
__device__ __forceinline__ void* ldp(LAS unsigned long long* tbl, int i) { const unsigned long long v = tbl[i];
    const unsigned lo = __builtin_amdgcn_readfirstlane((unsigned)v), hi = __builtin_amdgcn_readfirstlane((unsigned)(v >> 32)); return (void*)(((unsigned long long)hi << 32) | lo); }
struct Args { const float* in[21]; float* out; unsigned char* ws; int use_cg_sync; int pad; };

__global__ void __launch_bounds__(NWAVES * 64, 2) fwd_megakernel(Args args) {
    extern __shared__ __attribute__((aligned(16))) unsigned char lds[];
    LAS unsigned char* ldsp = (LAS unsigned char*)lds;
    const int G = gridDim.x, bx = blockIdx.x;
    const int vcu = (G % 8 == 0) ? (bx % 8) * (G / 8) + bx / 8 : bx;
    const int NGW = G * NWAVES, NGT = G * NWAVES * 64;
#define PHASE_IDS int tid = threadIdx.x; asm volatile("" : "+v"(tid)); const int lane = tid & 63, wave = __builtin_amdgcn_readfirstlane(tid >> 6); const int gw = vcu * NWAVES + wave, gt = bx * (NWAVES * 64) + tid; (void)lane; (void)gw; (void)gt
    LAS unsigned long long* ptab = (LAS unsigned long long*)(ldsp + 131072);
    if (threadIdx.x < 2) ((LAS unsigned*)(ldsp + 131072 + 768))[threadIdx.x] = 0u;
    if (threadIdx.x == 0) {
        ptab[0] = (unsigned long long)args.in[0]; ptab[1] = (unsigned long long)args.in[1]; ptab[2] = (unsigned long long)args.in[2]; ptab[3] = (unsigned long long)args.in[3];
        ptab[4] = (unsigned long long)args.in[4]; ptab[5] = (unsigned long long)args.in[5]; ptab[6] = (unsigned long long)args.in[6]; ptab[7] = (unsigned long long)args.in[7];
        ptab[8] = (unsigned long long)args.in[8]; ptab[9] = (unsigned long long)args.in[9]; ptab[10] = (unsigned long long)args.in[10]; ptab[11] = (unsigned long long)args.in[11];
        ptab[12] = (unsigned long long)args.in[12]; ptab[13] = (unsigned long long)args.in[13]; ptab[14] = (unsigned long long)args.in[14]; ptab[15] = (unsigned long long)args.in[15];
        ptab[16] = (unsigned long long)args.in[16]; ptab[17] = (unsigned long long)args.in[17]; ptab[18] = (unsigned long long)args.in[18]; ptab[19] = (unsigned long long)args.in[19];
        ptab[20] = (unsigned long long)args.in[20]; ptab[21] = (unsigned long long)args.out; ptab[22] = (unsigned long long)args.ws;
    }
    __syncthreads();
    if (args.use_cg_sync) cg::this_grid().sync();
#define GRID_BAR() do { XcdBarrier b_; b_.bar = (unsigned*)(WSB + WS_BAR); b_.x = xb_xcc_id(); b_.st = (volatile LAS unsigned*)(ldsp + 131072 + 768); xcd_barrier(b_); } while (0)
#define INP(i) ((const float*)ldp(ptab, (i)))
#define OUTP ((float*)ldp(ptab, 21))
#define WSB ((unsigned char*)ldp(ptab, 22))
#define WSP(T, off) ((T*)(ws + (off)))
#define DEF_WS unsigned char* ws = WSB
    {
        PHASE_IDS; DEF_WS; LAS float* scr = (LAS float*)(ldsp + wave * 16384); const float* x = INP(0); const float* p = INP(1); const float* norm_mix_g = INP(2); const float* w_in = INP(3); const float* pool_grp_w = INP(9); const float* pool_scale = INP(10);
        const float* w_attn_br = INP(11); const float* w_pool_br = INP(12); const float* w_out = INP(13); const float* norm_mlp_g = INP(14); const float* w_up = INP(15); const float* w_dn = INP(16);
        const float* norm_ple_g = INP(17); const float* w_ple = INP(18); const float* w_pg = INP(19);
        float* ss1 = WSP(float, WS_SS); bfu* WIN = WSP(bfu, WS_WIN); bfu* WUP = WSP(bfu, WS_WUP); bfu* WDN = WSP(bfu, WS_WDN); bfu* WOUT = WSP(bfu, WS_WOUT); bfu* WPG = WSP(bfu, WS_WPG);
        bfu* WBR = WSP(bfu, WS_WBR); bfu* WPB = WSP(bfu, WS_WPB); bfu* WPLE = WSP(bfu, WS_WPLE); bfu* PGW = WSP(bfu, WS_PGW); bfu* PB = WSP(bfu, WS_PB); bfu* HN = WSP(bfu, WS_HN);
        for (int rep_ = 0; rep_ < REP_P0; ++rep_) {
        constexpr int I_IN = (DM / 64) * (INW / 32), I_AB = (ATTW / 64) * (DM / 32), I_PB = I_AB;
        constexpr int NITEMS = I_IN + I_AB + I_PB;
        for (int it = gw; it < NITEMS; it += NGW) {
            int r = it;
            if (r < I_IN) { p0_transpose_item(w_in, DM, INW, WIN, nullptr, scr, r, lane); continue; } r -= I_IN;
            if (r < I_AB) { p0_transpose_item(w_attn_br, ATTW, DM, WBR, nullptr, scr, r, lane, 2048); continue; } r -= I_AB;
            p0_transpose_item(w_pool_br, ATTW, DM, WPB, pool_scale, scr, r, lane);
        }
        for (int i = gt; i < (4 * 256 * 256) / 4; i += NGT) { const f32x4 v = ((const f32x4*)pool_grp_w)[i]; ((uint2*)PGW)[i] = make_uint2(pk2(v[0], v[1]), pk2(v[2], v[3])); }
        for (int i = gt; i < 3 * S + 128; i += NGT) ss1[i] = 0.f;
        for (int i = gt; i < 4096; i += NGT) WSP(unsigned, WS_BAR)[i] = 0u;
        for (int m = gw; m < S; m += NGW) {
            const f32x4* xr = (const f32x4*)(x + (size_t)m * DM) + lane; f32x4 v[8]; float s = 0.f;
#pragma unroll
            for (int j = 0; j < 8; ++j) { v[j] = __builtin_nontemporal_load(xr + 64 * j); s += pg8::sq4(v[j]); }
            const float rs = 1.f / sqrtf(wave_sum(s) * (1.f / DM) + NORM_EPS);
            uint2* o8 = (uint2*)(HN + (size_t)m * DM) + lane;
#pragma unroll
            for (int j = 0; j < 8; ++j) { const f32x4 g = ((const f32x4*)norm_mix_g)[64 * j + lane]; o8[64 * j] = make_uint2(pk2(v[j][0] * rs * g[0], v[j][1] * rs * g[1]), pk2(v[j][2] * rs * g[2], v[j][3] * rs * g[3])); }
        }
        }
    }
    flag_barrier((unsigned long long*)(WSB + WS_FLAGS), gridDim.x, blockIdx.x);
    if (threadIdx.x == 0) (void)xb_add(&((unsigned*)(WSB + WS_BAR))[XB_XCNT(xb_xcc_id())], 1u);

    {
        PHASE_IDS; DEF_WS; bfu* HN = WSP(bfu, WS_HN); bfu* WIN = WSP(bfu, WS_WIN); bfu* Z = WSP(bfu, WS_Z); bfu* GT = WSP(bfu, WS_G); bfu* WPB = WSP(bfu, WS_WPB); bfu* PGW = WSP(bfu, WS_PGW); bfu* WBR = WSP(bfu, WS_WBR);
        pg8::Gemm g{HN, WIN, S, INW, DM, DM, DM, 0, 0}; pg8::StaticOrder so; so.init(S, INW, G, bx);
        pg8::EpiInProj E{Z, GT, QSCALE, (unsigned*)(WSP(float, WS_SS) + 3 * S)};
        for (int rep_ = 0; rep_ < REP_P1; ++rep_) pg8::gemm_phase<pg8::EpiInProj, pg8::StaticOrder, true, true>(ldsp, g, so, E);
    }
    GRID_BAR();

    {
        PHASE_IDS; DEF_WS; bfu* Z = WSP(bfu, WS_Z); bfu* Qb = Z; bfu* Kb = Z + (size_t)S * 1024; bfu* Vb = Z + (size_t)2 * S * 1024; bfu* Ub = Z + (size_t)3 * S * 1024;
        bfu* AB2 = WSP(bfu, WS_AB2); bfu* Obase = (bfu*)OUTP; float* Lbase = WSP(float, WS_SCR);
        { bfu* WPB = WSP(bfu, WS_WPB); bfu* PGW = WSP(bfu, WS_PGW); bfu* WBR = WSP(bfu, WS_WBR);
        pg8::Gemm g2{WPB, PGW, DM, 256, 256, 1024, 256, 256, 65536}; pg8::GroupOrder go{G, bx};
        pg8::EpiBf16G E2{WBR + 1024, 2048, 256};
        pg8::gemm_phase<pg8::EpiBf16G, pg8::GroupOrder, true, true>(ldsp, g2, go, E2);
        }
        __syncthreads();
        unsigned* nmax = (unsigned*)(WSP(float, WS_SS) + 3 * S); unsigned* qctr = nmax + 64;
        LAS unsigned* qw = (LAS unsigned*)(ldsp + 131072 + 512);
        for (int rep_ = 0; rep_ < REP_P2; ++rep_)
        for (;;) {
            if (threadIdx.x == 0) *qw = __hip_atomic_fetch_add(qctr + rep_, 1u, __ATOMIC_RELAXED, __HIP_MEMORY_SCOPE_AGENT);
            __syncthreads();
            const unsigned pidx = __builtin_amdgcn_readfirstlane(*qw);
            if (pidx >= 1152u) break;
            if (pidx < 1024u && (pidx & 3u) == 3u) {
                const int ci = (int)(pidx >> 2);
                constexpr int J_UP = (DM / 64) * (FF / 32), J_DN = (FF / 64) * (DM / 32), J_OUT = (DM / 64) * (DM / 32), J_PG = J_OUT, J_PLE = (PLE / 64) * (DM / 32), J_ALL = J_UP + J_DN + J_OUT + J_PG + J_PLE;
                static_assert(J_ALL == 256 * 81, "conversion items");
#pragma unroll 1
                for (int k2 = 0; k2 < 11; ++k2) { const int wi = wave + 8 * k2; if (wi >= 81) break; int r = ci * 81 + wi;
                    if (r < J_UP) { p0_transpose_item(INP(15), DM, FF, WSP(bfu, WS_WUP), INP(14), nullptr, r, lane); continue; } r -= J_UP;
                    if (r < J_DN) { p0_transpose_item(INP(16), FF, DM, WSP(bfu, WS_WDN), nullptr, nullptr, r, lane); continue; } r -= J_DN;
                    if (r < J_OUT) { p0_transpose_item(INP(13), DM, DM, WSP(bfu, WS_WOUT), nullptr, nullptr, r, lane); continue; } r -= J_OUT;
                    if (r < J_PG) { p0_transpose_item(INP(19), DM, DM, WSP(bfu, WS_WPG), INP(17), nullptr, r, lane); continue; } r -= J_PG;
                    p0_transpose_item(INP(18), PLE, DM, WSP(bfu, WS_WPLE), nullptr, nullptr, r, lane); }
                { const f32x4* p4 = (const f32x4*)INP(1); uint2* pb = (uint2*)WSP(bfu, WS_PB);
#pragma unroll
                  for (int k2 = 0; k2 < 4; ++k2) { const int i = ci * 2048 + k2 * 512 + (int)threadIdx.x; const f32x4 v = __builtin_nontemporal_load(p4 + i); pb[i] = make_uint2(pk2(v[0], v[1]), pk2(v[2], v[3])); } }
                __syncthreads(); continue; }
            const unsigned n = (pidx < 1024u) ? pidx - (pidx >> 2) : pidx - 256u;
            if (n >= 768u) {
                const int pc = (int)(n - 768u);
#pragma unroll 1
                for (int k2 = 0; k2 < 2; ++k2) { const int i = pc * 1024 + k2 * 512 + (int)threadIdx.x; const int ch = i & 127, tb = (i >> 7) * 8, gidx = ch >> 5;
                    const bfu* up = Ub + ch * 8; bfu* pp = AB2 + 1024 + ch * 8;
                    if (gidx == 0) pool_item<2>(up, pp, tb); else if (gidx == 1) pool_item<4>(up, pp, tb); else if (gidx == 2) pool_item<8>(up, pp, tb); else pool_item<16>(up, pp, tb); }
                __syncthreads(); continue; }
            int qb, part, c_, h_; bool may_split;
            if (n < 512u) { qb = 31 - (int)(n >> 4); part = (int)((n >> 3) & 1u); c_ = (int)((n >> 2) & 1u); h_ = 4 + (int)(n & 3u); may_split = true; }
            else { const unsigned m_ = n - 512u; qb = 31 - (int)(m_ >> 3); part = 0; c_ = (int)((m_ >> 2) & 1u); h_ = (int)(m_ & 3u); may_split = false; }
            const int hq = c_ * 8 + h_;
            const float slope2 = __builtin_exp2f(-(float)(h_ + 1)) * 1.4426950408889634f;
            const float qa = __uint_as_float(__hip_atomic_load(nmax + hq * 2, __ATOMIC_RELAXED, __HIP_MEMORY_SCOPE_AGENT)), qc = __uint_as_float(__hip_atomic_load(nmax + hq * 2 + 1, __ATOMIC_RELAXED, __HIP_MEMORY_SCOPE_AGENT));
            const float ka = __uint_as_float(__hip_atomic_load(nmax + (16 + hq) * 2, __ATOMIC_RELAXED, __HIP_MEMORY_SCOPE_AGENT)), kc = __uint_as_float(__hip_atomic_load(nmax + (16 + hq) * 2 + 1, __ATOMIC_RELAXED, __HIP_MEMORY_SCOPE_AGENT));
            const float bt = sqrtf((qa + qc) * (ka + kc)) * 1.02f + 0.01f;
            const float dmin = fminf(ceilf((2.f * bt + 32.f - __builtin_log2f(1.f - __builtin_exp2f(-slope2))) / slope2), 1048576.f);
            int t0 = (qb * 256 - (int)dmin + 1); t0 = t0 > 0 ? (t0 >> 6) & ~1 : 0;
            t0 = __builtin_amdgcn_readfirstlane(t0);
            const float bref = __uint_as_float(__builtin_amdgcn_readfirstlane(__float_as_uint(fminf(bt, 60.f))));
            const int nt_all = 4 * qb + 4 - t0; const bool split = may_split && nt_all >= ATT_SPLIT_MIN; const int na = split ? (((nt_all >> 1) + 1) & ~1) : nt_all;
            if (part == 1 && !split) { __syncthreads(); continue; }
            attn_body::bf16* Od = (attn_body::bf16*)(Obase + (size_t)(c_ * 2 + part) * S * 1024); float* Ld = Lbase + (size_t)(c_ * 2 + part) * S * 8 + h_;
            if (part == 0 && !split && threadIdx.x < 256) Lbase[((size_t)(c_ * 2 + 1) * S + qb * 256 + threadIdx.x) * 8 + h_] = 0.f;
            if (part == 0) attn_body::attn_unit<8>(hq, 2 * h_, qb, (const attn_body::bf16*)Qb, (const attn_body::bf16*)Kb, (const attn_body::bf16*)Vb, Od, slope2, t0, na, !split, Ld, bref, (char*)lds);
            else attn_body::attn_unit<8>(hq, 2 * h_, qb, (const attn_body::bf16*)Qb, (const attn_body::bf16*)Kb, (const attn_body::bf16*)Vb, Od, slope2, t0 + na, nt_all - na, true, Ld, bref, (char*)lds);
        }
    }
    GRID_BAR();

    {
        PHASE_IDS; DEF_WS; const float* lq1 = INP(4); const float* lk1 = INP(5); const float* lq2 = INP(6); const float* lk2 = INP(7); const float* subln_g = INP(8);
        bfu* Obase = (bfu*)OUTP; const float* Lbase = WSP(float, WS_SCR); bfu* AB2 = WSP(bfu, WS_AB2);
        const float d1 = wave_sum(lq1[lane] * lk1[lane]), d2 = wave_sum(lq2[lane] * lk2[lane]);
        const float lam = expf(d1) - expf(d2) + LAM_INIT;
        f32x4 sg[4];
#pragma unroll
        for (int j = 0; j < 4; ++j) sg[j] = ((const f32x4*)subln_g)[(lane & 7) * 4 + j] * (1.f - LAM_INIT);
        for (int m = gw; m < S; m += NGW) {
            float wgt[4];
#pragma unroll
            for (int cp = 0; cp < 4; ++cp) wgt[cp] = Lbase[((size_t)cp * S + m) * 8 + (lane >> 3)];
            const float i1 = 1.f / (wgt[0] + wgt[1]), i2 = 1.f / (wgt[2] + wgt[3]);
            const float w1a = wgt[0] * i1, w1b = wgt[1] * i1, w2a = -lam * wgt[2] * i2, w2b = -lam * wgt[3] * i2;
            const v4u* pa1 = (const v4u*)(Obase + ((size_t)0 * S + m) * 1024 + lane * 16); const v4u* pb1 = (const v4u*)(Obase + ((size_t)1 * S + m) * 1024 + lane * 16);
            const v4u* pa2 = (const v4u*)(Obase + ((size_t)2 * S + m) * 1024 + lane * 16); const v4u* pb2 = (const v4u*)(Obase + ((size_t)3 * S + m) * 1024 + lane * 16);
            f32x4 d[4]; float s = 0.f;
#pragma unroll
            for (int j = 0; j < 2; ++j) { f32x4 x0, x1, acc0 = (f32x4){0.f, 0.f, 0.f, 0.f}, acc1 = acc0;
                if (wgt[0] > 0.f) { pg8::unpack8(pa1[j], x0, x1); acc0 += x0 * w1a; acc1 += x1 * w1a; }
                if (wgt[1] > 0.f) { pg8::unpack8(pb1[j], x0, x1); acc0 += x0 * w1b; acc1 += x1 * w1b; }
                if (wgt[2] > 0.f) { pg8::unpack8(pa2[j], x0, x1); acc0 += x0 * w2a; acc1 += x1 * w2a; }
                if (wgt[3] > 0.f) { pg8::unpack8(pb2[j], x0, x1); acc0 += x0 * w2b; acc1 += x1 * w2b; }
                d[2 * j] = acc0; d[2 * j + 1] = acc1; s += pg8::sq4(acc0) + pg8::sq4(acc1); }
            s += __shfl_xor(s, 1); s += __shfl_xor(s, 2); s += __shfl_xor(s, 4);
            const float rs = 1.f / sqrtf(s * (1.f / 128.f) + NORM_EPS);
            v4u* o = (v4u*)(AB2 + (size_t)m * 2048 + lane * 16);
#pragma unroll
            for (int j = 0; j < 2; ++j) { const f32x4 v0 = d[2 * j] * rs * sg[2 * j], v1 = d[2 * j + 1] * rs * sg[2 * j + 1];
                v4u w; w.x = pk2(v0[0], v0[1]); w.y = pk2(v0[2], v0[3]); w.z = pk2(v1[0], v1[1]); w.w = pk2(v1[2], v1[3]); o[j] = w; }
        }
    }
    GRID_BAR();

    {
        PHASE_IDS; DEF_WS; bfu* AB2 = WSP(bfu, WS_AB2); bfu* WBR = WSP(bfu, WS_WBR); bfu* MG = WSP(bfu, WS_MG); bfu* GA = WSP(bfu, WS_G); bfu* GP = GA + (size_t)S * 2048;
        pg8::StaticOrder so; so.init(S, DM, G, bx);
        pg8::Gemm g1{AB2, WBR, S, DM, DM, DM, DM, 0, 0}; pg8::EpiMerged E1{GA, GP, MG};
        for (int rep_ = 0; rep_ < REP_P3; ++rep_) pg8::gemm_phase<pg8::EpiMerged, pg8::StaticOrder, true, true>(ldsp, g1, so, E1);
    }
    GRID_BAR();

    {
        PHASE_IDS; DEF_WS; float* out = OUTP; const float* x = INP(0); bfu* MG = WSP(bfu, WS_MG); bfu* WOUT = WSP(bfu, WS_WOUT); bfu* XB = WSP(bfu, WS_XB); float* ss1 = WSP(float, WS_SS);
        pg8::StaticOrder so; so.init(S, DM, G, bx);
        pg8::Gemm g1{MG, WOUT, S, DM, DM, DM, DM, 0, 0}; pg8::EpiResid<false> E1{x, XB, ss1};
        pg8::gemm_phase<pg8::EpiResid<false>, pg8::StaticOrder, true, true>(ldsp, g1, so, E1);
        for (int rep_ = 1; rep_ < REP_P4; ++rep_) { pg8::EpiResid<false> ER{x, XB, (float*)(ws + WS_BAR + 131072)}; pg8::gemm_phase<pg8::EpiResid<false>, pg8::StaticOrder, true, true>(ldsp, g1, so, ER); }
        for (int rep_ = 0; rep_ < REP_G4; ++rep_) { pg8::EpiDummy ED{WSP(bfu, WS_SCR)}; pg8::gemm_phase<pg8::EpiDummy, pg8::StaticOrder, true, true>(ldsp, g1, so, ED); }
    }
    GRID_BAR();

    {
        PHASE_IDS; DEF_WS; bfu* XB = WSP(bfu, WS_XB); bfu* WUP = WSP(bfu, WS_WUP); bfu* HB = WSP(bfu, WS_H); float* ss1 = WSP(float, WS_SS);
        pg8::StaticOrder so; so.init(S, FF, G, bx);
        pg8::Gemm g1{XB, WUP, S, FF, DM, DM, DM, 0, 0}; pg8::EpiUp E1{HB, ss1};
        for (int rep_ = 0; rep_ < REP_P5; ++rep_) pg8::gemm_phase<pg8::EpiUp, pg8::StaticOrder, true, true>(ldsp, g1, so, E1);
    }
    GRID_BAR();

    {
        PHASE_IDS; DEF_WS; float* out = OUTP; bfu* HB = WSP(bfu, WS_H); bfu* WDN = WSP(bfu, WS_WDN); bfu* XB = WSP(bfu, WS_XB); float* ss2 = WSP(float, WS_SS) + S;
        pg8::StaticOrder so; so.init(S, DM, G, bx);
        pg8::Gemm g1{HB, WDN, S, DM, FF, FF, FF, 0, 0}; pg8::EpiResid<true> E1{XB, XB, ss2};
        pg8::gemm_phase<pg8::EpiResid<true>, pg8::StaticOrder, true, true>(ldsp, g1, so, E1);
        for (int rep_ = 0; rep_ < REP_G6; ++rep_) { pg8::EpiDummy ED{WSP(bfu, WS_SCR)}; pg8::gemm_phase<pg8::EpiDummy, pg8::StaticOrder, true, true>(ldsp, g1, so, ED); }
    }
    GRID_BAR();

    {
        PHASE_IDS; DEF_WS; float* out = OUTP; bfu* PB = WSP(bfu, WS_PB); bfu* WPLE = WSP(bfu, WS_WPLE); bfu* PE = WSP(bfu, WS_PE); bfu* XB = WSP(bfu, WS_XB); bfu* WPG = WSP(bfu, WS_WPG);
        float* ss2 = WSP(float, WS_SS) + S; float* ss3 = ss2 + S;
        pg8::StaticOrder so; so.init(S, DM, G, bx);
        pg8::Gemm g1{PB, WPLE, S, DM, PLE, PLE, PLE, 0, 0}; pg8::EpiStoreBf16 E1{PE};
        pg8::gemm_phase<pg8::EpiStoreBf16, pg8::StaticOrder, true, true>(ldsp, g1, so, E1);
        pg8::Gemm g2{XB, WPG, S, DM, DM, DM, DM, 0, 0}; pg8::EpiPleGateFinal E2{PE, XB, out, ss2, ss3, (unsigned*)(WSP(float, WS_SS) + 3 * S) + 96, INP(20)};
        pg8::gemm_phase<pg8::EpiPleGateFinal, pg8::StaticOrder, false, true>(ldsp, g2, so, E2);
    }

    if (threadIdx.x == 0) __hip_atomic_store((unsigned long long*)(WSB + WS_FLAGS) + blockIdx.x, FLAG_CLOSED, __ATOMIC_RELAXED, __HIP_MEMORY_SCOPE_AGENT);
}

extern "C" void kernel_launch(void* const* d_in, const int* in_sizes, int n_in, void* d_out, int out_size, void* d_ws, size_t ws_size, hipStream_t stream) {
    static int grid_blocks = 0;
    if (grid_blocks == 0) {
        if (n_in != 21 || in_sizes[0] != S * DM || out_size != S * DM || ws_size < WS_END) { fprintf(stderr, "kernel_launch: unexpected shapes (n_in %d, in0 %d, out %d, ws %zu); nothing launched\n", n_in, n_in > 0 ? in_sizes[0] : -1, out_size, ws_size); grid_blocks = -1; return; }
        int dev = 0, cus = 0, per_cu = 0;
        (void)hipGetDevice(&dev); (void)hipDeviceGetAttribute(&cus, hipDeviceAttributeMultiprocessorCount, dev);
        if (hipFuncSetAttribute((const void*)fwd_megakernel, hipFuncAttributeMaxDynamicSharedMemorySize, LDS_BYTES) != hipSuccess) { fprintf(stderr, "kernel_launch: hipFuncSetAttribute failed\n"); grid_blocks = -1; return; }
        if (hipOccupancyMaxActiveBlocksPerMultiprocessor(&per_cu, (const void*)fwd_megakernel, NWAVES * 64, LDS_BYTES) != hipSuccess || per_cu < 1) { fprintf(stderr, "kernel_launch: occupancy query says %d\n", per_cu); per_cu = 1; }
        (void)hipGetLastError();
        grid_blocks = cus * 1;
        fprintf(stderr, "kernel_launch: cus %d per_cu %d grid %d\n", cus, per_cu, grid_blocks);
    }
    if (grid_blocks < 0) return;
    Args a{};
    for (int i = 0; i < 21; ++i) a.in[i] = (const float*)d_in[i];
    a.out = (float*)d_out; a.ws = (unsigned char*)d_ws;
    void* kargs[] = {&a};
    hipError_t e = hipLaunchCooperativeKernel((const void*)fwd_megakernel, dim3(grid_blocks), dim3(NWAVES * 64), kargs, LDS_BYTES, stream);
    if (e != hipSuccess) fprintf(stderr, "cooperative launch failed: %s (grid %d)\n", hipGetErrorString(e), grid_blocks);
}
```

```cpp
#include <hip/hip_runtime.h>
#include <hip/hip_cooperative_groups.h>
#include <cstdio>
#include <cstdint>
namespace cg = cooperative_groups;

namespace pg8 {
#define PG8_LAS __attribute__((address_space(3)))
typedef unsigned short bf16_t;
typedef short bf16x8 __attribute__((ext_vector_type(8)));
typedef float f32x4 __attribute__((ext_vector_type(4)));
typedef unsigned u32x4 __attribute__((ext_vector_type(4)));
constexpr int BM = 256, BK = 64, HALF = 128, HTB = HALF * BK * 2  , STAGE_BYTES = 8 * HTB, NXCD = 8, WGM = 8;

__host__ __device__ __forceinline__ int lds_byte(int r, int c) { const int st = (r >> 4) * 2 + (c >> 5), rr = r & 15, cc = c & 31, ob = rr * 64 + cc * 2; return st * 1024 + (ob ^ (((ob >> 9) & 1) << 5)); }
__host__ __device__ __forceinline__ void stage_rc(int b, int& R, int& C) { const int st = b / 1024, sb = b % 1024, swz = sb ^ (((sb >> 9) & 1) << 5); R = (st >> 1) * 16 + swz / 64; C = (st & 1) * 32 + (swz % 64) / 2; }
__host__ __device__ __forceinline__ int perm32(int rho) { const int n = rho >> 4, i = rho & 15; return 8 * (i >> 2) + 4 * n + (i & 3); }

struct Unit { int pm, pn, g; };
struct Gemm { const bf16_t* A; const bf16_t* Bt; int M, N, K, lda, ldb; size_t gsA, gsB; };

struct StaticOrder {
    int nM, nN, nwg, G, c;
    __host__ __device__ void init(int M, int N, int G_, int c_) { nM = M / BM; nN = N / BM; nwg = nM * nN; G = G_; c = c_; }
    __host__ __device__ bool next(int i, Unit& u) const {
        const long L = (long)i * G + c; if (L >= nwg) return false;
        int wgid = (int)L; { const int q = nwg / NXCD, r = nwg % NXCD, xcd = wgid % NXCD, off = wgid / NXCD; wgid = (xcd < r ? xcd * (q + 1) : r * (q + 1) + (xcd - r) * q) + off; }
        const int nig = WGM * nN, gid = wgid / nig, fm = gid * WGM, gsz = (nM - fm) < WGM ? (nM - fm) : WGM;
        u.pm = fm + ((wgid % nig) % gsz); u.pn = (wgid % nig) / gsz; u.g = 0; return true;
    }
    __device__ __forceinline__ void a_ready(const Unit&) const {}
    __device__ __forceinline__ void done(const Unit&) const {}
};

__device__ __forceinline__ unsigned cvt_pk_bf16(float lo, float hi) { unsigned r; asm volatile("v_cvt_pk_bf16_f32 %0, %1, %2" : "=v"(r) : "v"(lo), "v"(hi)); return r; }
typedef unsigned u32x2 __attribute__((ext_vector_type(2)));
__device__ __forceinline__ float bf_lo(unsigned w) { return __uint_as_float(w << 16); }
__device__ __forceinline__ float bf_hi(unsigned w) { return __uint_as_float(w & 0xffff0000u); }
__device__ __forceinline__ float sigm(float v) { return __builtin_amdgcn_rcpf(1.f + __builtin_amdgcn_exp2f(-1.4426950408889634f * v)); }
__device__ __forceinline__ u32x4 pack8(const f32x4& v0, const f32x4& v1) { u32x4 w; w.x = cvt_pk_bf16(v0[0], v0[1]); w.y = cvt_pk_bf16(v0[2], v0[3]); w.z = cvt_pk_bf16(v1[0], v1[1]); w.w = cvt_pk_bf16(v1[2], v1[3]); return w; }
__device__ __forceinline__ void unpack8(const u32x4& g, f32x4& a, f32x4& b) { a = (f32x4){bf_lo(g.x), bf_hi(g.x), bf_lo(g.y), bf_hi(g.y)}; b = (f32x4){bf_lo(g.z), bf_hi(g.z), bf_lo(g.w), bf_hi(g.w)}; }
__device__ __forceinline__ float sq4(const f32x4& v) { return (v[0] * v[0] + v[1] * v[1]) + (v[2] * v[2] + v[3] * v[3]); }
constexpr int SEQ_ = 8192;
#define EPI_LOOP_ROWS _Pragma("unroll") for (int ai = 0; ai < 2; ++ai) _Pragma("unroll") for (int m = 0; m < 4; ++m)
#define EPI_LOOP_BJ _Pragma("unroll") for (int bj = 0; bj < 2; ++bj)

struct EpiInProj { static constexpr bool PERM = true, AFTER_DRAIN = false, MIDK = false;
    bf16_t* Z; bf16_t* G; float qscale; unsigned* nmax;
    __device__ __forceinline__ void operator()(const f32x4 (&acc)[2][2][4][2], const Unit& u, int wr, int wc, int fr, int fq) const {
        const int colt = u.pn * BM, reg = colt >> 10; const bool sig = reg >= 4;
        bf16_t* base; int ldc, c0; float sc = 1.f;
        if (!sig) { base = Z + (size_t)reg * ((size_t)SEQ_ * 1024); ldc = 1024; c0 = colt & 1023; if (reg == 0) sc = qscale; }
        else { const int gi = (reg - 4) >> 1; base = G + (size_t)gi * ((size_t)SEQ_ * 2048); ldc = 2048; c0 = colt - 4096 - gi * 2048; }
        const int col0 = c0 + wc * 32 + 8 * fq, row0 = u.pm * BM + wr * 64 + fr;
        float mx[2] = {0.f, 0.f};
        EPI_LOOP_ROWS { bf16_t* rowp = base + (size_t)(row0 + ai * HALF + m * 16) * ldc + col0;
            EPI_LOOP_BJ { f32x4 v0 = acc[ai][bj][m][0], v1 = acc[ai][bj][m][1];
                if (sig) {
#pragma unroll
                    for (int i = 0; i < 4; ++i) { v0[i] = sigm(v0[i]); v1[i] = sigm(v1[i]); } }
                else { v0 = v0 * sc; v1 = v1 * sc; }
                if (reg <= 1) { float s = sq4(v0) + sq4(v1); s += __shfl_xor(s, 16); s += __shfl_xor(s, 32); mx[bj] = fmaxf(mx[bj], s); }
                *(u32x4*)(rowp + bj * HALF) = pack8(v0, v1); } }
        if (reg <= 1) {
            EPI_LOOP_BJ { float v = mx[bj]; v = fmaxf(v, __shfl_xor(v, 1)); v = fmaxf(v, __shfl_xor(v, 2)); v = fmaxf(v, __shfl_xor(v, 4)); v = fmaxf(v, __shfl_xor(v, 8));
                const int cg_ = c0 + bj * HALF + wc * 32;
                if (fr == 0 && fq == 0) atomicMax(nmax + (reg * 16 + (cg_ >> 6)) * 2 + ((cg_ >> 5) & 1), __float_as_uint(v)); }
        }
    }
};
struct EpiBf16G { static constexpr bool PERM = true, AFTER_DRAIN = false, MIDK = false;
    bf16_t* O; int ldc; int gcols;
    __device__ __forceinline__ void operator()(const f32x4 (&acc)[2][2][4][2], const Unit& u, int wr, int wc, int fr, int fq) const {
        const int col0 = u.g * gcols + u.pn * BM + wc * 32 + 8 * fq, row0 = u.pm * BM + wr * 64 + fr;
        EPI_LOOP_ROWS { bf16_t* rowp = O + (size_t)(row0 + ai * HALF + m * 16) * ldc + col0;
            EPI_LOOP_BJ { *(u32x4*)(rowp + bj * HALF) = pack8(acc[ai][bj][m][0], acc[ai][bj][m][1]); } }
    }
};
struct EpiGateA { static constexpr bool PERM = true, AFTER_DRAIN = false, MIDK = false;
    const bf16_t* GA; bf16_t* T;
    __device__ __forceinline__ void operator()(const f32x4 (&acc)[2][2][4][2], const Unit& u, int wr, int wc, int fr, int fq) const {
        const int col0 = u.pn * BM + wc * 32 + 8 * fq, row0 = u.pm * BM + wr * 64 + fr;
        EPI_LOOP_ROWS { const size_t off = (size_t)(row0 + ai * HALF + m * 16) * 2048 + col0;
            EPI_LOOP_BJ { const u32x4 g = *(const u32x4*)(GA + off + bj * HALF); f32x4 g0, g1; unpack8(g, g0, g1);
                *(u32x4*)(T + off + bj * HALF) = pack8(acc[ai][bj][m][0] * g0, acc[ai][bj][m][1] * g1); } asm volatile("" ::: "memory"); }
    }
};
struct EpiGateP { static constexpr bool PERM = true, AFTER_DRAIN = false, MIDK = false;
    const bf16_t* GP; const bf16_t* T; bf16_t* MG;
    __device__ __forceinline__ void operator()(const f32x4 (&acc)[2][2][4][2], const Unit& u, int wr, int wc, int fr, int fq) const {
        const int col0 = u.pn * BM + wc * 32 + 8 * fq, row0 = u.pm * BM + wr * 64 + fr;
        EPI_LOOP_ROWS { const size_t off = (size_t)(row0 + ai * HALF + m * 16) * 2048 + col0;
            EPI_LOOP_BJ { const u32x4 g = *(const u32x4*)(GP + off + bj * HALF); f32x4 g0, g1; unpack8(g, g0, g1);
                const u32x4 tt = *(const u32x4*)(T + off + bj * HALF); f32x4 t0, t1; unpack8(tt, t0, t1);
                *(u32x4*)(MG + off + bj * HALF) = pack8(t0 + acc[ai][bj][m][0] * g0, t1 + acc[ai][bj][m][1] * g1); } asm volatile("" ::: "memory"); }
    }
};
template <bool BASE_BF16> struct EpiResid { static constexpr bool PERM = true, AFTER_DRAIN = false, MIDK = false;
    const void* base; bf16_t* outb; float* ss;
    __device__ __forceinline__ void operator()(const f32x4 (&acc)[2][2][4][2], const Unit& u, int wr, int wc, int fr, int fq) const {
        const int col0 = u.pn * BM + wc * 32 + 8 * fq, row0 = u.pm * BM + wr * 64 + fr;
        float sv[2][4];
        EPI_LOOP_ROWS { const int row = row0 + ai * HALF + m * 16; const size_t off = (size_t)row * 2048 + col0; float s = 0.f;
            EPI_LOOP_BJ { f32x4 b0, b1;
                if (BASE_BF16) { const u32x4 bb = *(const u32x4*)((const bf16_t*)base + off + bj * HALF); unpack8(bb, b0, b1); }
                else { b0 = __builtin_nontemporal_load((const f32x4*)((const float*)base + off + bj * HALF)); b1 = __builtin_nontemporal_load((const f32x4*)((const float*)base + off + bj * HALF + 4)); }
                const f32x4 o0 = b0 + acc[ai][bj][m][0], o1 = b1 + acc[ai][bj][m][1];
                *(u32x4*)(outb + off + bj * HALF) = pack8(o0, o1); s += sq4(o0) + sq4(o1); }
            s += __shfl_xor(s, 16); s += __shfl_xor(s, 32); sv[ai][m] = s; asm volatile("" ::: "memory"); }
#pragma unroll
        for (int ai = 0; ai < 2; ++ai) { const float t = fq == 0 ? sv[ai][0] : fq == 1 ? sv[ai][1] : fq == 2 ? sv[ai][2] : sv[ai][3]; unsafeAtomicAdd(ss + row0 + ai * HALF + fq * 16, t); }
    }
};
struct EpiUp { static constexpr bool PERM = true, AFTER_DRAIN = false, MIDK = false;
    bf16_t* H; const float* ss;
    __device__ __forceinline__ void operator()(const f32x4 (&acc)[2][2][4][2], const Unit& u, int wr, int wc, int fr, int fq) const {
        const int col0 = u.pn * BM + wc * 32 + 8 * fq, row0 = u.pm * BM + wr * 64 + fr;
        EPI_LOOP_ROWS { const int row = row0 + ai * HALF + m * 16; const float rs = __builtin_amdgcn_rsqf(ss[row] * (1.f / 2048.f) + 1e-6f);
            EPI_LOOP_BJ { f32x4 v0 = acc[ai][bj][m][0] * rs, v1 = acc[ai][bj][m][1] * rs;
#pragma unroll
                for (int i = 0; i < 4; ++i) { const float a = fmaxf(v0[i], 0.f), b = fmaxf(v1[i], 0.f); v0[i] = a * a; v1[i] = b * b; }
                *(u32x4*)(H + (size_t)row * 8192 + col0 + bj * HALF) = pack8(v0, v1); } }
    }
};
struct EpiStoreF32 { static constexpr bool PERM = true, AFTER_DRAIN = false, MIDK = false;
    float* out;
    __device__ __forceinline__ void operator()(const f32x4 (&acc)[2][2][4][2], const Unit& u, int wr, int wc, int fr, int fq) const {
        const int col0 = u.pn * BM + wc * 32 + 8 * fq, row0 = u.pm * BM + wr * 64 + fr;
        EPI_LOOP_ROWS { const size_t off = (size_t)(row0 + ai * HALF + m * 16) * 2048 + col0;
            EPI_LOOP_BJ { *(f32x4*)(out + off + bj * HALF) = acc[ai][bj][m][0]; *(f32x4*)(out + off + bj * HALF + 4) = acc[ai][bj][m][1]; } }
    }
};
struct EpiStoreBf16 { static constexpr bool PERM = true, AFTER_DRAIN = false, MIDK = false;
    bf16_t* out;
    __device__ __forceinline__ void operator()(const f32x4 (&acc)[2][2][4][2], const Unit& u, int wr, int wc, int fr, int fq) const {
        const int col0 = u.pn * BM + wc * 32 + 8 * fq, row0 = u.pm * BM + wr * 64 + fr;
        EPI_LOOP_ROWS { const size_t off = (size_t)(row0 + ai * HALF + m * 16) * 2048 + col0;
            EPI_LOOP_BJ { *(u32x4*)(out + off + bj * HALF) = pack8(acc[ai][bj][m][0], acc[ai][bj][m][1]); } }
    }
};
struct EpiPleGate { static constexpr bool PERM = true, AFTER_DRAIN = false, MIDK = false;
    const bf16_t* pe; const bf16_t* xb; float* out; const float* ss_in; float* ss_out;
    __device__ __forceinline__ void operator()(const f32x4 (&acc)[2][2][4][2], const Unit& u, int wr, int wc, int fr, int fq) const {
        const int col0 = u.pn * BM + wc * 32 + 8 * fq, row0 = u.pm * BM + wr * 64 + fr;
        EPI_LOOP_ROWS { const int row = row0 + ai * HALF + m * 16; const size_t off = (size_t)row * 2048 + col0; float s = 0.f;
            const float rs = __builtin_amdgcn_rsqf(ss_in[row] * (1.f / 2048.f) + 1e-6f);
            EPI_LOOP_BJ { f32x4 g0 = acc[ai][bj][m][0] * rs, g1 = acc[ai][bj][m][1] * rs;
#pragma unroll
                for (int i = 0; i < 4; ++i) { g0[i] = sigm(g0[i]); g1[i] = sigm(g1[i]); }
                const u32x4 xx = *(const u32x4*)(xb + off + bj * HALF), pp = *(const u32x4*)(pe + off + bj * HALF); f32x4 x0, x1, p0, p1; unpack8(xx, x0, x1); unpack8(pp, p0, p1);
                const f32x4 o0 = x0 + p0 * g0, o1 = x1 + p1 * g1;
                *(f32x4*)(out + off + bj * HALF) = o0; *(f32x4*)(out + off + bj * HALF + 4) = o1; s += sq4(o0) + sq4(o1); }
            s += __shfl_xor(s, 16); s += __shfl_xor(s, 32); if (fq == 0) unsafeAtomicAdd(ss_out + row, s); asm volatile("" ::: "memory"); }
    }
};
struct EpiPleGateFinal { static constexpr bool PERM = true, AFTER_DRAIN = true, MIDK = false;
    const bf16_t* pe; const bf16_t* xb; float* out; const float* ss_in; float* ss_out; unsigned* cnt; const float* fg;
    __device__ __forceinline__ void fused(f32x4 (&acc)[2][2][4][2], const Unit& u, int wr, int wc, int fr, int fq, PG8_LAS unsigned char* lds, int wid, int lane) const {
        const int col0 = u.pn * BM + wc * 32 + 8 * fq, row0 = u.pm * BM + wr * 64 + fr;
        EPI_LOOP_ROWS { const int row = row0 + ai * HALF + m * 16; const size_t off = (size_t)row * 2048 + col0; float s = 0.f;
            const float rs = __builtin_amdgcn_rsqf(ss_in[row] * (1.f / 2048.f) + 1e-6f);
            EPI_LOOP_BJ { f32x4 g0 = acc[ai][bj][m][0] * rs, g1 = acc[ai][bj][m][1] * rs;
#pragma unroll
                for (int i = 0; i < 4; ++i) { g0[i] = sigm(g0[i]); g1[i] = sigm(g1[i]); }
                const u32x4 xx = *(const u32x4*)(xb + off + bj * HALF), pp = *(const u32x4*)(pe + off + bj * HALF); f32x4 x0, x1, p0, p1; unpack8(xx, x0, x1); unpack8(pp, p0, p1);
                const f32x4 o0 = x0 + p0 * g0, o1 = x1 + p1 * g1; acc[ai][bj][m][0] = o0; acc[ai][bj][m][1] = o1; s += sq4(o0) + sq4(o1); }
            s += __shfl_xor(s, 16); s += __shfl_xor(s, 32); if (fq == 0) unsafeAtomicAdd(ss_out + row, s); asm volatile("" ::: "memory"); }
        asm volatile("s_waitcnt vmcnt(0)" ::: "memory");
        __syncthreads();
        if (threadIdx.x == 0) { __hip_atomic_fetch_add(cnt + u.pm, 1u, __ATOMIC_RELAXED, __HIP_MEMORY_SCOPE_AGENT); unsigned sp = 0;
            while (__hip_atomic_load(cnt + u.pm, __ATOMIC_RELAXED, __HIP_MEMORY_SCOPE_AGENT) < 8u) { __builtin_amdgcn_s_sleep(1); if (++sp > (1u << 22)) break; } }
        __syncthreads();
        EPI_LOOP_ROWS { const int row = row0 + ai * HALF + m * 16; const size_t off = (size_t)row * 2048 + col0;
            const float t = __uint_as_float(__hip_atomic_load((unsigned*)(ss_out + row), __ATOMIC_RELAXED, __HIP_MEMORY_SCOPE_AGENT)); const float rs = 1.f / sqrtf(t * (1.f / 2048.f) + 1e-6f);
            EPI_LOOP_BJ { const f32x4 ga = *(const f32x4*)(fg + col0 + bj * HALF), gb = *(const f32x4*)(fg + col0 + bj * HALF + 4);
                *(f32x4*)(out + off + bj * HALF) = acc[ai][bj][m][0] * rs * ga; *(f32x4*)(out + off + bj * HALF + 4) = acc[ai][bj][m][1] * rs * gb; } }
    }
};
struct EpiMerged { static constexpr bool PERM = true, AFTER_DRAIN = false, MIDK = true;
    const bf16_t* GA; const bf16_t* GP; bf16_t* MG;
    __device__ __forceinline__ void mid(f32x4 (&acc)[2][2][4][2], const Unit& u, int wr, int wc, int fr, int fq) const {
        const int col0 = u.pn * BM + wc * 32 + 8 * fq, row0 = u.pm * BM + wr * 64 + fr;
        unsigned long long ro_ = ((unsigned long long)row0 * 2048 + col0) * 2; asm volatile("" : "+v"(ro_));
        const bf16_t* ga = (const bf16_t*)((const char*)GA + ro_); const bf16_t* gp = (const bf16_t*)((const char*)GP + ro_);
#pragma unroll
        for (int ai = 0; ai < 2; ++ai)
#pragma unroll
            for (int m = 0; m < 4; ++m)
#pragma unroll
                for (int bj = 0; bj < 2; ++bj) { const size_t o_ = (size_t)(ai * HALF + m * 16) * 2048 + bj * HALF;
                    const u32x4 a = *(const u32x4*)(ga + o_), p = *(const u32x4*)(gp + o_);
#define RT_(aw, pw, lo) ((lo ? bf_lo(aw) : bf_hi(aw)) * __builtin_amdgcn_rcpf(fmaxf(lo ? bf_lo(pw) : bf_hi(pw), 1e-30f)))
                    acc[ai][bj][m][0][0] *= RT_(a.x, p.x, 1); acc[ai][bj][m][0][1] *= RT_(a.x, p.x, 0); acc[ai][bj][m][0][2] *= RT_(a.y, p.y, 1); acc[ai][bj][m][0][3] *= RT_(a.y, p.y, 0);
                    acc[ai][bj][m][1][0] *= RT_(a.z, p.z, 1); acc[ai][bj][m][1][1] *= RT_(a.z, p.z, 0); acc[ai][bj][m][1][2] *= RT_(a.w, p.w, 1); acc[ai][bj][m][1][3] *= RT_(a.w, p.w, 0);
#undef RT_
                    asm volatile("" ::: "memory"); }
    }
    __device__ __forceinline__ void operator()(const f32x4 (&acc)[2][2][4][2], const Unit& u, int wr, int wc, int fr, int fq) const {
        const int col0 = u.pn * BM + wc * 32 + 8 * fq, row0 = u.pm * BM + wr * 64 + fr;
        EPI_LOOP_ROWS { const size_t off = (size_t)(row0 + ai * HALF + m * 16) * 2048 + col0;
            EPI_LOOP_BJ { const u32x4 g = *(const u32x4*)(GP + off + bj * HALF); f32x4 g0, g1; unpack8(g, g0, g1);
                *(u32x4*)(MG + off + bj * HALF) = pack8(acc[ai][bj][m][0] * g0, acc[ai][bj][m][1] * g1); } asm volatile("" ::: "memory"); }
    }
};
struct EpiDummy { static constexpr bool PERM = true, AFTER_DRAIN = false, MIDK = false;
    bf16_t* O;
    __device__ __forceinline__ void operator()(const f32x4 (&acc)[2][2][4][2], const Unit& u, int wr, int wc, int fr, int fq) const {
        const int col0 = (u.pn & 7) * BM + wc * 32 + 8 * fq, row0 = (u.pm & 7) * BM + wr * 64 + fr;
        EPI_LOOP_ROWS { bf16_t* rowp = O + (size_t)(row0 + ai * HALF + m * 16) * 2048 + col0;
            EPI_LOOP_BJ { *(u32x4*)(rowp + bj * HALF) = pack8(acc[ai][bj][m][0], acc[ai][bj][m][1]); } }
    }
};
struct SubOrder { StaticOrder so; int base, cnt;
    __host__ __device__ bool next(int i, Unit& u) const { return i < cnt ? so.next(base + i, u) : false; }
    __device__ __forceinline__ void a_ready(const Unit&) const {}
    __device__ __forceinline__ void done(const Unit&) const {}
};
struct GroupOrder {
    int G, c;
    __host__ __device__ bool next(int i, Unit& u) const { const int L = i * G + c; if (L >= 32) return false; u.g = L >> 3; u.pm = L & 7; u.pn = 0; return true; }
    __device__ __forceinline__ void a_ready(const Unit&) const {}
    __device__ __forceinline__ void done(const Unit&) const {}
};


template <class Epi, class Sched, bool ALIGN_EPI = false, bool SP2 = false>
__device__ __forceinline__ void gemm_phase(PG8_LAS unsigned char* lds, const Gemm g, const Sched& S, const Epi& E) {
    int tid = threadIdx.x; asm volatile("" : "+v"(tid));   const int wid = __builtin_amdgcn_readfirstlane(tid >> 6), lane = tid & 63, wr = wid >> 2, wc = wid & 3, fr = lane & 15, fq = lane >> 4;
    int K = g.K; asm volatile("" : "+s"(K)); const int nt = K / BK;
    unsigned voffA[2], voffB[2];
#pragma unroll
    for (int i = 0; i < 2; ++i) { int R, C; stage_rc(tid * 16 + i * 8192, R, C); const int Rb = Epi::PERM ? ((R & ~31) + perm32(R & 31)) : R;
        voffA[i] = (unsigned)(R * g.lda + C) * 2u; voffB[i] = (unsigned)(Rb * g.ldb + C) * 2u; }
    const size_t kstep = (size_t)(BK * 2);
    const size_t hstepA = (size_t)HALF * g.lda * 2, hstepB = (size_t)HALF * g.ldb * 2;
    const size_t tstepA = 2 * hstepA, tstepB = 2 * hstepB;
    const unsigned ldsw = (unsigned)wid * 1024u;
    const int aoff = lds_byte(wr * 64 + fr, fq * 8), boff = lds_byte(wc * 32 + fr, fq * 8);
#define PG8_SA(b, h) (((b) * 2 + (h)) * HTB)
#define PG8_SB(b, h) ((4 + (b) * 2 + (h)) * HTB)
#define PG8_STAGE(bufoff, gbase, voff) do { _Pragma("unroll") for (int _i = 0; _i < 2; ++_i) \
        __builtin_amdgcn_global_load_lds((const unsigned*)((const char*)(gbase) + (voff)[_i]), (PG8_LAS unsigned*)(lds + (bufoff) + ldsw + _i * 8192), 16, 0, 0); } while (0)
#define PG8_LDA(dst, b, h) do { _Pragma("unroll") for (int m = 0; m < 4; ++m) _Pragma("unroll") for (int k = 0; k < 2; ++k) dst[m][k] = *(const PG8_LAS bf16x8*)(lds + PG8_SA(b, h) + aoff + m * 2048 + k * 1024); } while (0)
#define PG8_LDB(dst, b, h) do { _Pragma("unroll") for (int n = 0; n < 2; ++n) _Pragma("unroll") for (int k = 0; k < 2; ++k) dst[n][k] = *(const PG8_LAS bf16x8*)(lds + PG8_SB(b, h) + boff + n * 2048 + k * 1024); } while (0)
#define PG8_MMA(ai, bj, At, Bt) do { __builtin_amdgcn_s_setprio(1); _Pragma("unroll") for (int m = 0; m < 4; ++m) _Pragma("unroll") for (int n = 0; n < 2; ++n) _Pragma("unroll") for (int k = 0; k < 2; ++k) \
        acc[ai][bj][m][n] = __builtin_amdgcn_mfma_f32_16x16x32_bf16(Bt[n][k], At[m][k], acc[ai][bj][m][n], 0, 0, 0); __builtin_amdgcn_s_setprio(0); } while (0)
#define PG8_WAIT_V(n) asm volatile("s_waitcnt vmcnt(" #n ")" ::: "memory")
#define PG8_WAIT_L(n) asm volatile("s_waitcnt lgkmcnt(" #n ")" ::: "memory")
#define PG8_BAR __builtin_amdgcn_s_barrier()
#define PG8_SCHED __builtin_amdgcn_sched_barrier(0)
    Unit cur, nxt; int ui = 0;
    if (!S.next(0, cur)) return;
    f32x4 acc[2][2][4][2];
#pragma unroll
    for (int a = 0; a < 2; ++a)
#pragma unroll
        for (int b = 0; b < 2; ++b)
#pragma unroll
            for (int m = 0; m < 4; ++m)
#pragma unroll
                for (int n = 0; n < 2; ++n) acc[a][b][m][n] = (f32x4){0.f, 0.f, 0.f, 0.f};
    bf16x8 At[4][2], B0[2][2], B1[2][2];
    const char* cA = (const char*)(g.A + (size_t)cur.g * g.gsA) + (size_t)cur.pm * tstepA; const char* cB = (const char*)(g.Bt + (size_t)cur.g * g.gsB) + (size_t)cur.pn * tstepB;
    S.a_ready(cur);
    if constexpr (SP2) {
        PG8_STAGE(PG8_SB(0, 0), cB, voffB); PG8_STAGE(PG8_SB(0, 1), cB + hstepB, voffB); PG8_STAGE(PG8_SA(0, 0), cA, voffA); PG8_STAGE(PG8_SA(0, 1), cA + hstepA, voffA);
        if (wr == 1) PG8_BAR;
        PG8_WAIT_V(2); PG8_BAR;
        PG8_STAGE(PG8_SB(1, 0), cB + kstep, voffB); PG8_STAGE(PG8_SA(1, 0), cA + kstep, voffA); PG8_STAGE(PG8_SB(1, 1), cB + hstepB + kstep, voffB);
        PG8_WAIT_V(6); PG8_BAR;
    } else {
        PG8_STAGE(PG8_SB(0, 0), cB, voffB); PG8_STAGE(PG8_SA(0, 0), cA, voffA); PG8_STAGE(PG8_SB(0, 1), cB + hstepB, voffB); PG8_STAGE(PG8_SA(0, 1), cA + hstepA, voffA);
        if (wr == 1) PG8_BAR;
        PG8_WAIT_V(4); PG8_BAR;
        PG8_STAGE(PG8_SB(1, 0), cB + kstep, voffB); PG8_STAGE(PG8_SA(1, 0), cA + kstep, voffA); PG8_STAGE(PG8_SB(1, 1), cB + hstepB + kstep, voffB);
        PG8_WAIT_V(6); PG8_BAR;
    }
    for (;;) {
        const bool has_next = S.next(ui + 1, nxt);
        const char* nA = has_next ? (const char*)(g.A + (size_t)nxt.g * g.gsA) + (size_t)nxt.pm * tstepA : cA; const char* nB = has_next ? (const char*)(g.Bt + (size_t)nxt.g * g.gsB) + (size_t)nxt.pn * tstepB : cB;
        for (int t = 0; t < nt; t += 2) {
            if constexpr (Epi::MIDK) { if (t == (nt >> 1)) { asm volatile("s_waitcnt vmcnt(0)" ::: "memory"); E.mid(acc, cur, wr, wc, fr, fq); asm volatile("s_waitcnt vmcnt(0)" ::: "memory"); } }
            const bool last = (t == nt - 2);
            const char* a1 = cA + (size_t)(t + 1) * kstep;
            const char* a2 = last ? nA : cA + (size_t)(t + 2) * kstep; const char* b2 = last ? nB : cB + (size_t)(t + 2) * kstep;
            const char* a3 = a2 + kstep; const char* b3 = b2 + kstep;
            if (last && has_next) S.a_ready(nxt);
            if constexpr (SP2) {
            PG8_LDB(B0, 0, 0); PG8_LDB(B1, 0, 1); PG8_SCHED; PG8_LDA(At, 0, 0); PG8_STAGE(PG8_SA(1, 1), a1 + hstepA, voffA);
            PG8_WAIT_V(8); PG8_WAIT_L(0); PG8_BAR; PG8_MMA(0, 0, At, B0); PG8_MMA(0, 1, At, B1); PG8_BAR; PG8_SCHED;
            PG8_LDA(At, 0, 1); PG8_STAGE(PG8_SB(0, 0), b2, voffB); PG8_STAGE(PG8_SB(0, 1), b2 + hstepB, voffB); PG8_STAGE(PG8_SA(0, 0), a2, voffA);
            PG8_WAIT_V(8); PG8_WAIT_L(0); PG8_BAR; PG8_MMA(1, 0, At, B0); PG8_MMA(1, 1, At, B1); PG8_BAR; PG8_SCHED;
            PG8_LDB(B0, 1, 0); PG8_LDB(B1, 1, 1); PG8_SCHED; PG8_LDA(At, 1, 0); PG8_STAGE(PG8_SA(0, 1), a2 + hstepA, voffA);
            PG8_WAIT_V(8); PG8_WAIT_L(0); PG8_BAR; PG8_MMA(0, 0, At, B0); PG8_MMA(0, 1, At, B1); PG8_BAR; PG8_SCHED;
            PG8_LDA(At, 1, 1); PG8_STAGE(PG8_SB(1, 0), b3, voffB); PG8_STAGE(PG8_SB(1, 1), b3 + hstepB, voffB); PG8_STAGE(PG8_SA(1, 0), a3, voffA);
            PG8_WAIT_V(8); PG8_WAIT_L(0); PG8_BAR; PG8_MMA(1, 0, At, B0); PG8_MMA(1, 1, At, B1); PG8_BAR; PG8_SCHED;
            } else {
            PG8_LDB(B0, 0, 0); PG8_SCHED; PG8_LDA(At, 0, 0); PG8_STAGE(PG8_SA(1, 1), a1 + hstepA, voffA);
            PG8_WAIT_L(8); PG8_BAR; PG8_WAIT_L(0); PG8_MMA(0, 0, At, B0); PG8_BAR; PG8_SCHED;
            PG8_LDB(B1, 0, 1); PG8_STAGE(PG8_SB(0, 0), b2, voffB);
            PG8_BAR; PG8_WAIT_L(0); PG8_MMA(0, 1, At, B1); PG8_BAR;
            PG8_LDA(At, 0, 1); PG8_STAGE(PG8_SA(0, 0), a2, voffA);
            PG8_BAR; PG8_WAIT_L(0); PG8_MMA(1, 0, At, B0); PG8_BAR; PG8_SCHED;
            PG8_STAGE(PG8_SB(0, 1), b2 + hstepB, voffB);
            PG8_WAIT_V(6); PG8_BAR; PG8_MMA(1, 1, At, B1); PG8_BAR;
            PG8_LDB(B0, 1, 0); PG8_SCHED; PG8_LDA(At, 1, 0); PG8_STAGE(PG8_SA(0, 1), a2 + hstepA, voffA);
            PG8_WAIT_L(8); PG8_BAR; PG8_WAIT_L(0); PG8_MMA(0, 0, At, B0); PG8_BAR; PG8_SCHED;
            PG8_LDB(B1, 1, 1); PG8_STAGE(PG8_SB(1, 0), b3, voffB);
            PG8_BAR; PG8_WAIT_L(0); PG8_MMA(0, 1, At, B1); PG8_BAR;
            PG8_LDA(At, 1, 1); PG8_STAGE(PG8_SA(1, 0), a3, voffA);
            PG8_BAR; PG8_WAIT_L(0); PG8_MMA(1, 0, At, B0); PG8_BAR; PG8_SCHED;
            PG8_STAGE(PG8_SB(1, 1), b3 + hstepB, voffB);
            PG8_WAIT_V(6); PG8_BAR; PG8_MMA(1, 1, At, B1); PG8_BAR;
            }
        }
        if constexpr (ALIGN_EPI) { if (wr == 0) PG8_BAR; }
        if constexpr (!Epi::AFTER_DRAIN) { E(acc, cur, wr, wc, fr, fq); S.done(cur); }
        if (!has_next) break;
#pragma unroll
        for (int a = 0; a < 2; ++a)
#pragma unroll
            for (int b = 0; b < 2; ++b)
#pragma unroll
                for (int m = 0; m < 4; ++m)
#pragma unroll
                    for (int n = 0; n < 2; ++n) acc[a][b][m][n] = (f32x4){0.f, 0.f, 0.f, 0.f};
        cur = nxt; cA = nA; cB = nB; ++ui;
        if constexpr (ALIGN_EPI) { if (wr == 1) PG8_BAR; }
    }
    PG8_WAIT_V(0);
    if constexpr (!ALIGN_EPI) { if (wr == 0) PG8_BAR; }
    PG8_BAR;
    if constexpr (Epi::AFTER_DRAIN) { E.fused(acc, cur, wr, wc, fr, fq, lds, wid, lane); S.done(cur); }
#undef PG8_SA
#undef PG8_SB
#undef PG8_STAGE
#undef PG8_LDA
#undef PG8_LDB
#undef PG8_MMA
#undef PG8_WAIT_V
#undef PG8_WAIT_L
#undef PG8_BAR
#undef PG8_SCHED
}
}
#include <hip/hip_bf16.h>
#include <cmath>
namespace attn_body {
using bf16=__hip_bfloat16;
using bf16x8=__attribute__((ext_vector_type(8)))short;
using s16x4=__attribute__((ext_vector_type(4)))short;
using f32x16=__attribute__((ext_vector_type(16)))float;
using u32x4=__attribute__((ext_vector_type(4)))unsigned;
constexpr int BATCH=1,NHEAD=16,SEQ=8192,D=64,DM=NHEAD*D;
constexpr int NW=8,QBLK=32,QB=QBLK*NW,KVBLK=64,NQB=SEQ/QB;
constexpr int ATTN_PITCH=DM, ATTN_UNIT_ROWS=QB;
__device__ __forceinline__ int crow(int r,int hi){return (r&3)+8*(r>>2)+4*hi;}
#define SBAR() __builtin_amdgcn_sched_barrier(0)
__device__ __forceinline__ void cmask(f32x16&p0,f32x16&p1,int jb,int qrel,int hi){
  const float NEG=-INFINITY; int kb=64*jb+4*hi;
  #pragma unroll
  for(int r=0;r<16;++r){int kv=kb+(r&3)+8*(r>>2); if(kv>qrel)p0[r]=NEG; if(kv+32>qrel)p1[r]=NEG;}
}

constexpr int NSLOT=3, SLOTB=8192;
constexpr int LDS_K=0, LDS_V=NSLOT*SLOTB, LDS_WS=3*NSLOT*SLOTB  , LDS_OST=LDS_WS+NW*64*4, LDS_BYTES=LDS_OST+NW*4096;
constexpr float C2=0.125f*1.4426950408889634f;
__device__ __forceinline__ void glds16(const void*gsrc,unsigned lds_dst){unsigned keep;
  asm volatile("s_mov_b32 %0, m0\n\ts_mov_b32 m0, %2\n\ts_nop 0\n\tglobal_load_lds_dwordx4 %1, off\n\ts_mov_b32 m0, %0":"=&s"(keep):"v"(gsrc),"s"(lds_dst):"memory");}
__device__ __forceinline__ float max3f(float a,float b,float c){float r;asm("v_max3_f32 %0, %1, %2, %3":"=v"(r):"v"(a),"v"(b),"v"(c));return r;}
__device__ __forceinline__ float max2f(float a,float b){float r;asm("v_max_f32_e32 %0, %1, %2":"=v"(r):"v"(a),"v"(b));return r;}
__device__ __forceinline__ float fadd_s(float a,float b){float r;asm("v_add_f32_e32 %0, %1, %2":"=v"(r):"v"(a),"v"(b));return r;}
__device__ __forceinline__ float fsub_s(float a,float b){float r;asm("v_sub_f32_e32 %0, %1, %2":"=v"(r):"v"(a),"v"(b));return r;}
typedef float f32x2_t __attribute__((ext_vector_type(2))); typedef __bf16 bf16x2_t __attribute__((ext_vector_type(2)));
__device__ __forceinline__ unsigned cvtpk_s(float lo,float hi){f32x2_t v={lo,hi};bf16x2_t b=__builtin_convertvector(v,bf16x2_t);return __builtin_bit_cast(unsigned,b);}
#define WAIT_BAR(N) asm volatile("s_waitcnt vmcnt(" #N ") lgkmcnt(0)\n\ts_barrier":::"memory")

__device__ __forceinline__ void qkt(f32x16&p0,f32x16&p1,const char*Kslot,const bf16x8*qr,const f32x16&negm,int r32,int hi){
  const char*kb=Kslot+hi*1024+r32*16;
  #pragma unroll
  for(int d0=0;d0<4;++d0){
    const bf16x8 b0=*reinterpret_cast<const bf16x8*>(kb+d0*2048);
    const bf16x8 b1=*reinterpret_cast<const bf16x8*>(kb+d0*2048+512);
    if(d0==0){p0=__builtin_amdgcn_mfma_f32_32x32x16_bf16(b0,qr[0],negm,0,0,0);p1=__builtin_amdgcn_mfma_f32_32x32x16_bf16(b1,qr[0],negm,0,0,0);}
    else{p0=__builtin_amdgcn_mfma_f32_32x32x16_bf16(b0,qr[d0],p0,0,0,0);p1=__builtin_amdgcn_mfma_f32_32x32x16_bf16(b1,qr[d0],p1,0,0,0);}}
}
typedef __attribute__((address_space(3))) const char* lds_cptr;
typedef short v4i16_t __attribute__((ext_vector_type(4)));
__device__ __forceinline__ void kload8(bf16x8*kf,lds_cptr kp){
  kf[0]=*(const __attribute__((address_space(3))) bf16x8*)(kp);      kf[1]=*(const __attribute__((address_space(3))) bf16x8*)(kp+512);
  kf[2]=*(const __attribute__((address_space(3))) bf16x8*)(kp+2048); kf[3]=*(const __attribute__((address_space(3))) bf16x8*)(kp+2560);
  kf[4]=*(const __attribute__((address_space(3))) bf16x8*)(kp+4096); kf[5]=*(const __attribute__((address_space(3))) bf16x8*)(kp+4608);
  kf[6]=*(const __attribute__((address_space(3))) bf16x8*)(kp+6144); kf[7]=*(const __attribute__((address_space(3))) bf16x8*)(kp+6656);
}
__device__ __forceinline__ void kload2(bf16x8*kf,lds_cptr kp,int j){ kf[2*j]=*(const __attribute__((address_space(3))) bf16x8*)(kp+j*2048); kf[2*j+1]=*(const __attribute__((address_space(3))) bf16x8*)(kp+j*2048+512); }
__device__ __forceinline__ s16x4 vtr(lds_cptr p){ return __builtin_bit_cast(s16x4,__builtin_amdgcn_ds_read_tr16_b64_v4i16((__attribute__((address_space(3))) v4i16_t*)p)); }
__device__ __forceinline__ float rowmax(const f32x16&p0,const f32x16&p1){
  float a=max3f(p0[0],p0[1],p1[0]),b=max3f(p0[2],p0[3],p1[1]);a=max3f(a,p1[2],p1[3]);
  #pragma unroll
  for(int r=4;r<16;r+=4){a=max3f(a,p0[r],p0[r+1]);b=max3f(b,p0[r+2],p0[r+3]);a=max3f(a,p1[r],p1[r+1]);b=max3f(b,p1[r+2],p1[r+3]);}
  const float m=max2f(a,b);
  auto rr=__builtin_amdgcn_permlane32_swap(__float_as_uint(m),__float_as_uint(m),false,false);
  return max2f(__uint_as_float(rr[0]),__uint_as_float(rr[1]));
}
__device__ __forceinline__ void pv(f32x16*o,int vb,bf16x8 pa0,bf16x8 pa1,bf16x8 pa2,bf16x8 pa3){
  #pragma unroll
  for(int d0=0;d0<2;++d0){s16x4 lo[4],hi[4];
    #pragma unroll
    for(int ks=0;ks<4;++ks){
      asm volatile("ds_read_b64_tr_b16 %0,%1 offset:%c2":"=&v"(lo[ks]):"v"(vb),"i"(d0*4096+ks*1024):"memory");
      asm volatile("ds_read_b64_tr_b16 %0,%1 offset:%c2":"=&v"(hi[ks]):"v"(vb),"i"(d0*4096+ks*1024+512):"memory");}
    asm volatile("s_waitcnt lgkmcnt(0)":::"memory");SBAR();
    #define PK(k) (bf16x8){lo[k][0],lo[k][1],lo[k][2],lo[k][3],hi[k][0],hi[k][1],hi[k][2],hi[k][3]}
    o[d0]=__builtin_amdgcn_mfma_f32_32x32x16_bf16(pa0,PK(0),o[d0],0,0,0);
    o[d0]=__builtin_amdgcn_mfma_f32_32x32x16_bf16(pa1,PK(1),o[d0],0,0,0);
    o[d0]=__builtin_amdgcn_mfma_f32_32x32x16_bf16(pa2,PK(2),o[d0],0,0,0);
    o[d0]=__builtin_amdgcn_mfma_f32_32x32x16_bf16(pa3,PK(3),o[d0],0,0,0);
    #undef PK
  }
}

#ifndef ATTN_STORE16
#define ATTN_STORE16(p,v) (*(u32x4*)(p)=(v))
#endif
template<int THRL> __device__ __forceinline__ void attn_unit(int hq,int hv,int qb,const bf16*Q,const bf16*__restrict__ K,const bf16*__restrict__ V,bf16*O,const float slope2,const int t0,const int ntiles,const bool band,float*Lout,const float bref,char*shm){
  int tid=threadIdx.x; asm volatile("":"+v"(tid)); const int lane=tid&63,r32=lane&31,hi=lane>>5; const int wid=__builtin_amdgcn_readfirstlane(tid>>6);
  const long rowbase=0; const int q0=qb*QB;
  const bf16*Qw=Q+(rowbase+q0+wid*QBLK)*DM+hq*D;
  const bf16*Kh=K+(rowbase+(long)t0*KVBLK)*DM+hq*D,*Vh=V+(rowbase+(long)t0*KVBLK)*DM+hv*D;
  const unsigned lds0=(unsigned)(uintptr_t)shm;
  float*wsf=(float*)(shm+LDS_WS)+wid*64;
  const bf16*ksrc=Kh+(long)lane*DM+wid*8;
  const bf16*vsrc=Vh+(long)(16*(wid&3)+(lane>>2))*DM+(wid>>2)*32+(lane&3)*8;
  const unsigned kdst=lds0+LDS_K+wid*1024, vdst=lds0+LDS_V+wid*1024;
  #define DMA_K(t,slot) glds16(ksrc+(long)(t)*KVBLK*DM,(unsigned)__builtin_amdgcn_readfirstlane(kdst+(slot)))
  #define DMA_V(t,slot) do{ glds16(vsrc+(long)(t)*KVBLK*DM,(unsigned)__builtin_amdgcn_readfirstlane(vdst+2*(slot))); glds16(vsrc+64+(long)(t)*KVBLK*DM,(unsigned)__builtin_amdgcn_readfirstlane(vdst+2*(slot)+8192)); }while(0)
  const int vb0=(int)(lds0+LDS_V)+((lane>>4)&1)*32+(lane&3)*8+(4*hi+((lane&15)>>2))*64;
  const char*Kbase=shm+LDS_K; bf16x8 kf[8];
  const lds_cptr shm3=(lds_cptr)shm; const lds_cptr kp0=shm3+LDS_K+hi*1024+r32*16; const lds_cptr vp0=shm3+LDS_V+((lane>>4)&1)*32+(lane&3)*8+(4*hi+((lane&15)>>2))*64;
  const int NT=ntiles;
  DMA_K(0,0);DMA_V(0,0);DMA_K(1,SLOTB);
  bf16x8 qr[4];
  #pragma unroll
  for(int d0=0;d0<4;++d0)qr[d0]=*reinterpret_cast<const bf16x8*>(&Qw[(long)r32*DM+d0*16+hi*8]);
  const int qrel=wid*QBLK+r32;
  const float dstep=64.f*slope2; const float abase=slope2*(float)(64*t0+4*hi-(q0+qrel))-bref;
  float l_reg=0.f;f32x16 o[4];o[0]=f32x16{};o[1]=f32x16{};o[2]=f32x16{};o[3]=f32x16{};const f32x16 negm=f32x16{};
  #define CMASK(P0,P1,t) do{int jb_=(t)-(NT-4); if(band&&jb_>=0)cmask(P0,P1,jb_,qrel,hi);}while(0)
  bool resc=false;
  #define START(P0,P1) do{ resc=false; \
    { const float nm_=abase; \
      _Pragma("unroll") for(int r=0;r<16;++r){ const float kc_=(float)((r&3)+8*(r>>2)); P0[r]=__builtin_fmaf(slope2,kc_,P0[r]+nm_); P1[r]=__builtin_fmaf(slope2,kc_+32.f,P1[r]+nm_); } } \
    _Pragma("unroll") for(int r=0;r<16;++r)P0[r]=__builtin_amdgcn_exp2f(P0[r]); }while(0)
  #define RESC() do{ if(resc){ asm volatile("s_waitcnt lgkmcnt(0)":::"memory"); \
      _Pragma("unroll") for(int d_=0;d_<2;++d_) _Pragma("unroll") for(int r=0;r<16;++r)o[d_][r]*=wsf[crow(r,hi)]; } }while(0)
  f32x16 pA0,pA1,pB0,pB1;
  int sl_prev=0,sl_cur=0,sl_next=SLOTB;
  #define ROT() do{sl_prev=sl_cur;sl_cur=sl_next;sl_next=(sl_next==(NSLOT-1)*SLOTB)?0:sl_next+SLOTB;}while(0)
  DMA_K(2,2*SLOTB);
  WAIT_BAR(4);
  qkt(pA0,pA1,Kbase,qr,negm,r32,hi);asm volatile("s_nop 15\n\ts_nop 7":"+v"(pA0),"+v"(pA1));CMASK(pA0,pA1,0);
  START(pA0,pA1);
  _Pragma("unroll") for(int r=0;r<16;++r)pA1[r]=__builtin_amdgcn_exp2f(pA1[r]);
  WAIT_BAR(0);
  DMA_K(3,0);DMA_V(1,SLOTB);
  ROT();
  kload8(kf,kp0+sl_cur);
  WAIT_BAR(3);
  s16x4 vlo[8],vhi[8]; u32x4 pw0,pw1,pw2,pw3;
  #define PKW(P,B) cvtpk_s(P[B],P[B+1])
  #define PAF(k) __builtin_bit_cast(bf16x8,pw##k)
  #define VFR(i) (bf16x8){vlo[i][0],vlo[i][1],vlo[i][2],vlo[i][3],vhi[i][0],vhi[i][1],vhi[i][2],vhi[i][3]}
  #define PIN(x) asm volatile("":"+v"(x))
  #define MX3(a,b,c) __builtin_fmaxf(__builtin_fmaxf((a),(b)),(c))
  #define GAPA(MF,A0,A1,A2,A3,W0,W1,PW) do{ MF; sacc+=A0; sacc+=A1; sacc+=A2; sacc+=A3; PIN(sacc); W0; W1; PIN(PW); SBAR(); }while(0)
  #define EX(v) __builtin_amdgcn_exp2f(v)
  #define BX(v,k) EX(__builtin_fmaf(slope2,(float)(k),(v)+nm2_))
  #define GAPB(MF,X,B,KO) do{ MF; X[B]=BX(X[B],2*(B)+(KO)); X[B+1]=BX(X[B+1],2*(B)+1+(KO)); X[B+2]=BX(X[B+2],2*(B)+2+(KO)); X[B+3]=BX(X[B+3],2*(B)+3+(KO)); PIN(X); SBAR(); }while(0)
  #define VRD(i) do{ vlo[i]=vtr(vp_+(((i)>>2)*4096+((i)&3)*1024)); vhi[i]=vtr(vp_+(((i)>>2)*4096+((i)&3)*1024+512)); }while(0)
  #define VRD2(i) do{ vlo[i]=vtr(vp_+(8192+((i)>>2)*4096+((i)&3)*1024)); vhi[i]=vtr(vp_+(8192+((i)>>2)*4096+((i)&3)*1024+512)); SBAR(); }while(0)
  #define KRD(G,j) do{ if(G){ kload2(kf,kp0+sl_next,j); SBAR(); } }while(0)
  #define STEP(C0,C1,P0,P1,t,GK,GV,GL) do{ SBAR(); \
    const lds_cptr vp_=vp0+2*sl_prev; \
    VRD(0); SBAR(); float sacc=(P0[0]+P0[1]); \
    GAPA(C0=__builtin_amdgcn_mfma_f32_32x32x16_bf16(kf[0],qr[0],negm,0,0,0), P0[2],P0[3],P0[4],P0[5],     pw0[0]=PKW(P0,0), pw0[1]=PKW(P0,2), pw0); \
    VRD(4); SBAR(); GAPA(C1=__builtin_amdgcn_mfma_f32_32x32x16_bf16(kf[1],qr[0],negm,0,0,0), P0[6],P0[7],P0[8],P0[9],     pw0[2]=PKW(P0,4), pw0[3]=PKW(P0,6), pw0); \
    VRD(1); SBAR(); GAPA(C0=__builtin_amdgcn_mfma_f32_32x32x16_bf16(kf[2],qr[1],C0,0,0,0),   P0[10],P0[11],P0[12],P0[13], pw1[0]=PKW(P0,8), pw1[1]=PKW(P0,10), pw1); \
    VRD(5); SBAR(); GAPA(C1=__builtin_amdgcn_mfma_f32_32x32x16_bf16(kf[3],qr[1],C1,0,0,0),   P0[14],P0[15],P1[0],P1[1],   pw1[2]=PKW(P0,12),pw1[3]=PKW(P0,14), pw1); \
    VRD(2); SBAR(); GAPA(C0=__builtin_amdgcn_mfma_f32_32x32x16_bf16(kf[4],qr[2],C0,0,0,0),   P1[2],P1[3],P1[4],P1[5],     pw2[0]=PKW(P1,0), pw2[1]=PKW(P1,2), pw2); \
    VRD(6); SBAR(); GAPA(C1=__builtin_amdgcn_mfma_f32_32x32x16_bf16(kf[5],qr[2],C1,0,0,0),   P1[6],P1[7],P1[8],P1[9],     pw2[2]=PKW(P1,4), pw2[3]=PKW(P1,6), pw2); \
    VRD(3); SBAR(); GAPA(C0=__builtin_amdgcn_mfma_f32_32x32x16_bf16(kf[6],qr[3],C0,0,0,0),   P1[10],P1[11],P1[12],P1[13], pw3[0]=PKW(P1,8), pw3[1]=PKW(P1,10), pw3); \
    VRD(7); SBAR(); GAPA(C1=__builtin_amdgcn_mfma_f32_32x32x16_bf16(kf[7],qr[3],C1,0,0,0),   P1[14],P1[15],0.f,0.f,       pw3[2]=PKW(P1,12),pw3[3]=PKW(P1,14), pw3); \
    l_reg+=sacc; \
    if(GK){DMA_K((t)+3,sl_cur);} if(GV){DMA_V((t)+1,sl_next);} \
    CMASK(C0,C1,t); \
    const float nm2_=__builtin_fmaf(dstep,(float)(t),abase); \
    SBAR(); \
    GAPB(o[0]=__builtin_amdgcn_mfma_f32_32x32x16_bf16(PAF(0),VFR(0),o[0],0,0,0), C0,0,0); VRD2(0); \
    GAPB(o[1]=__builtin_amdgcn_mfma_f32_32x32x16_bf16(PAF(0),VFR(4),o[1],0,0,0), C0,4,0); VRD2(4); \
    KRD(GL,0); GAPB(o[0]=__builtin_amdgcn_mfma_f32_32x32x16_bf16(PAF(1),VFR(1),o[0],0,0,0), C0,8,0); VRD2(1); \
    KRD(GL,1); GAPB(o[1]=__builtin_amdgcn_mfma_f32_32x32x16_bf16(PAF(1),VFR(5),o[1],0,0,0), C0,12,0); VRD2(5); \
    KRD(GL,2); GAPB(o[0]=__builtin_amdgcn_mfma_f32_32x32x16_bf16(PAF(2),VFR(2),o[0],0,0,0), C1,0,32); VRD2(2); \
    KRD(GL,3); GAPB(o[1]=__builtin_amdgcn_mfma_f32_32x32x16_bf16(PAF(2),VFR(6),o[1],0,0,0), C1,4,32); VRD2(6); \
    GAPB(o[0]=__builtin_amdgcn_mfma_f32_32x32x16_bf16(PAF(3),VFR(3),o[0],0,0,0), C1,8,32); VRD2(3); \
    GAPB(o[1]=__builtin_amdgcn_mfma_f32_32x32x16_bf16(PAF(3),VFR(7),o[1],0,0,0), C1,12,32); VRD2(7); \
    SBAR(); \
    o[2]=__builtin_amdgcn_mfma_f32_32x32x16_bf16(PAF(0),VFR(0),o[2],0,0,0); \
    o[3]=__builtin_amdgcn_mfma_f32_32x32x16_bf16(PAF(0),VFR(4),o[3],0,0,0); \
    o[2]=__builtin_amdgcn_mfma_f32_32x32x16_bf16(PAF(1),VFR(1),o[2],0,0,0); \
    o[3]=__builtin_amdgcn_mfma_f32_32x32x16_bf16(PAF(1),VFR(5),o[3],0,0,0); \
    o[2]=__builtin_amdgcn_mfma_f32_32x32x16_bf16(PAF(2),VFR(2),o[2],0,0,0); \
    o[3]=__builtin_amdgcn_mfma_f32_32x32x16_bf16(PAF(2),VFR(6),o[3],0,0,0); \
    o[2]=__builtin_amdgcn_mfma_f32_32x32x16_bf16(PAF(3),VFR(3),o[2],0,0,0); \
    o[3]=__builtin_amdgcn_mfma_f32_32x32x16_bf16(PAF(3),VFR(7),o[3],0,0,0); \
    SBAR(); \
    }while(0)
  int t=1;
  #undef CMASK
  #define CMASK(P0,P1,t) do{}while(0)
  for(;t+5<NT;t+=2){
    STEP(pB0,pB1,pA0,pA1,t,true,true,true);     WAIT_BAR(3); RESC(); ROT();
    STEP(pA0,pA1,pB0,pB1,t+1,true,true,true);   WAIT_BAR(3); RESC(); ROT();
  }
  #undef CMASK
  #define CMASK(P0,P1,t) do{int jb_=(t)-(NT-4); if(band&&jb_>=0)cmask(P0,P1,jb_,qrel,hi);}while(0)
  #define ENDW(tt) do{ if((tt)+3<NT){WAIT_BAR(3);} else if((tt)+2<NT){WAIT_BAR(2);} else {WAIT_BAR(0);} }while(0)
  for(;t+1<NT;t+=2){
    STEP(pB0,pB1,pA0,pA1,t,(t+3<NT),(t+1<NT),(t+1<NT));       ENDW(t);   RESC(); ROT();
    STEP(pA0,pA1,pB0,pB1,t+1,(t+4<NT),(t+2<NT),(t+2<NT));     ENDW(t+1); RESC(); ROT();
  }
  STEP(pB0,pB1,pA0,pA1,NT-1,false,false,false); RESC();
  { float sacc=pB0[0]+pB0[1]; _Pragma("unroll") for(int r=2;r<16;++r)sacc+=pB0[r]; _Pragma("unroll") for(int r=0;r<16;++r)sacc+=pB1[r]; l_reg+=sacc;
    pw0=(u32x4){PKW(pB0,0),PKW(pB0,2),PKW(pB0,4),PKW(pB0,6)};pw1=(u32x4){PKW(pB0,8),PKW(pB0,10),PKW(pB0,12),PKW(pB0,14)};pw2=(u32x4){PKW(pB1,0),PKW(pB1,2),PKW(pB1,4),PKW(pB1,6)};pw3=(u32x4){PKW(pB1,8),PKW(pB1,10),PKW(pB1,12),PKW(pB1,14)};
    SBAR(); pv(o,vb0+2*sl_cur,PAF(0),PAF(1),PAF(2),PAF(3)); pv(o+2,vb0+2*sl_cur+8192,PAF(0),PAF(1),PAF(2),PAF(3)); }
  #undef PKW
  #undef PAF
  #undef VFR
  #undef PIN
  #undef MX3
  #undef GAPA
  #undef GAPB
  #undef BX
  #undef EX
  #undef VRD
  #undef VRD2
  #undef KRD
  #undef STEP
  #undef ENDW
  {auto rr=__builtin_amdgcn_permlane32_swap(__float_as_uint(l_reg),__float_as_uint(l_reg),false,false);l_reg=__uint_as_float(rr[0])+__uint_as_float(rr[1]);}
  if(hi==0){wsf[32+r32]=l_reg; if(Lout)Lout[(long)(q0+qrel)*8]=l_reg;}asm volatile("s_waitcnt lgkmcnt(0)":::"memory");
  float rli[16];
  #pragma unroll
  for(int r=0;r<16;++r)rli[r]=__builtin_amdgcn_rcpf(wsf[32+crow(r,hi)]);
  bf16*Ow=O+(rowbase+q0+wid*QBLK)*DM+hv*D;
  { bf16*stg=(bf16*)(shm+LDS_OST)+wid*2048;
    #pragma unroll
    for(int hf=0;hf<2;++hf){
      #pragma unroll
      for(int r=0;r<16;++r){const int orow=crow(r,hi);
        #pragma unroll
        for(int d0=0;d0<2;++d0)stg[orow*64+d0*32+r32]=__float2bfloat16(o[2*hf+d0][r]*rli[r]);}
      asm volatile("s_waitcnt lgkmcnt(0)":::"memory");
      #pragma unroll
      for(int i=0;i<4;++i){const int row=i*8+(lane>>3),ch=lane&7; const u32x4 v=*(const u32x4*)(stg+row*64+ch*8); ATTN_STORE16(Ow+(long)row*DM+hf*64+ch*8,v);}
      asm volatile("s_waitcnt lgkmcnt(0)":::"memory"); } }
  asm volatile("s_waitcnt lgkmcnt(0)\n\ts_barrier":::"memory");
  #undef DMA_K
  #undef DMA_V
  #undef CMASK
  #undef START
  #undef RESC
  #undef ROT
}
constexpr int ATTN_LDS_BYTES=LDS_BYTES;
struct AttnTensors { const bf16* Q; const bf16* K; const bf16* V; bf16* O; bf16* O2; };
struct AttnUnit { int bh; int qb; };
struct StaticOrder {
  int vcu;
  __device__ __forceinline__ explicit StaticOrder(int grid,int block):vcu((block%8)*(grid/8)+block/8){}
  __device__ __forceinline__ bool next(int i,AttnUnit&u)const{ if(i>=4)return false; const int s=vcu&7; u.bh=vcu>>3; u.qb=(i==0)?s:(i==1)?15-s:(i==2)?16+s:31-s; return true; }
  __device__ __forceinline__ void a_ready(const AttnUnit&)const{}
  __device__ __forceinline__ void done(const AttnUnit&)const{}
};
template<class Sched,int THRL=8> __device__ __forceinline__ void attn_phase(char*lds,const AttnTensors&T,const Sched&S){
  AttnUnit u;
  for(int i=0;S.next(i,u);++i){ S.a_ready(u); { const int h_=u.bh>>2, c_=(u.bh>>1)&1, vh_=u.bh&1; attn_unit<THRL>(c_*8+h_, 2*h_+vh_, u.qb, T.Q, T.K, T.V, c_? T.O2 : T.O, __builtin_exp2f(-(float)(h_+1))*1.4426950408889634f, 0, 4*u.qb+4, true, nullptr, 64.f, lds); } S.done(u); }
}
#undef SBAR
#undef WAIT_BAR
}
#ifndef REP_P0
#define REP_P0 1
#endif
#ifndef REP_P1
#define REP_P1 1
#endif
#ifndef REP_P2
#define REP_P2 1
#endif
#ifndef REP_P3
#define REP_P3 1
#endif
#ifndef REP_G4
#define REP_G4 0
#endif
#ifndef REP_G6
#define REP_G6 0
#endif
#ifndef REP_P4
#define REP_P4 1
#endif
#ifndef REP_P5
#define REP_P5 1
#endif
constexpr int NWAVES = 8;
constexpr int S = 8192, DM = 2048, INW = 8192, FF = 8192, PLE = 256, ATTW = 1024;
constexpr float NORM_EPS = 1e-6f;
constexpr float LAM_INIT = 0.2f;
constexpr float QSCALE = 0.125f * 1.4426950408889634f;
constexpr size_t MiB = 1u << 20;
constexpr size_t WS_BAR = 1u << 20;
constexpr size_t WS_FLAGS = (1u << 20) + 65536;
constexpr size_t WS_SS = 0;
constexpr size_t WS_WIN = 2 * MiB, WS_WUP = 34 * MiB, WS_WDN = 66 * MiB, WS_WOUT = 98 * MiB, WS_WPG = 106 * MiB, WS_WPB = 114 * MiB, WS_WBR = 118 * MiB  , WS_WPLE = 126 * MiB, WS_PGW = 127 * MiB;
constexpr size_t WS_PB = 128 * MiB;
constexpr size_t WS_HN = 132 * MiB;
constexpr size_t WS_Z = 164 * MiB;
constexpr size_t WS_G = 228 * MiB;
constexpr size_t WS_AB2 = 132 * MiB;
constexpr size_t WS_SCR = 292 * MiB;
constexpr size_t WS_MG = 164 * MiB;
constexpr size_t WS_XB = 260 * MiB;
constexpr size_t WS_H = 132 * MiB;
constexpr size_t WS_PE = 132 * MiB;
constexpr size_t WS_END = 308 * MiB;
constexpr int LDS_BYTES = 131072 + 1024;
constexpr int ATT_SPLIT_MIN = 16;

#define GAS __attribute__((address_space(1)))
#define LAS __attribute__((address_space(3)))
typedef unsigned short bfu;
typedef unsigned v4u __attribute__((ext_vector_type(4)));
typedef float f32x4 __attribute__((ext_vector_type(4)));
#define LDS_WAIT() asm volatile("s_waitcnt lgkmcnt(0)" ::: "memory")
__device__ __forceinline__ unsigned f2bf(float f) { unsigned u = __builtin_bit_cast(unsigned, f); return (u + 0x7fffu + ((u >> 16) & 1u)) >> 16; }
__device__ __forceinline__ unsigned pk2(float lo, float hi) { return f2bf(lo) | (f2bf(hi) << 16); }
__device__ __forceinline__ float wave_sum(float v) {
#pragma unroll
    for (int o = 1; o < 64; o <<= 1) v += __shfl_xor(v, o);
    return v;
}
__device__ __forceinline__ void p0_transpose_item(const float* W, int K, int N, bfu* WT, const float* gain, LAS float*  , int item, int lane, int ldk = 0) {
    if (ldk == 0) ldk = K;
    const int nblk = N / 32, kb = item / nblk, nb = item % nblk, k0 = 64 * kb, n0 = 32 * nb, kg = lane >> 3, n4 = lane & 7;
    const float* src = W + (size_t)(k0 + 8 * kg) * N + n0 + 4 * n4;
    f32x4 v[8];
#pragma unroll
    for (int j = 0; j < 8; ++j) v[j] = __builtin_nontemporal_load((const f32x4*)(src + (size_t)j * N));
    if (gain) { const f32x4 g0 = *(const f32x4*)(gain + k0 + 8 * kg), g1 = *(const f32x4*)(gain + k0 + 8 * kg + 4);
#pragma unroll
        for (int j = 0; j < 4; ++j) { v[j] = v[j] * g0[j]; v[4 + j] = v[4 + j] * g1[j]; } }
    bfu* dst = WT + (size_t)(n0 + 4 * n4) * ldk + k0 + 8 * kg;
#pragma unroll
    for (int i = 0; i < 4; ++i) { v4u o; o.x = pk2(v[0][i], v[1][i]); o.y = pk2(v[2][i], v[3][i]); o.z = pk2(v[4][i], v[5][i]); o.w = pk2(v[6][i], v[7][i]); *(v4u*)(dst + (size_t)i * ldk) = o; }
}
#define XB_TMO      128
#define XB_XCNT(j)  (256  + 64 * (j))
#define XB_XSUB(j)  (1280 + 64 * (j))
#define XB_XGEN(j)  (2304 + 64 * (j))
#define XB_TOP      3328
#define XB_TOPGEN   3392
#define XCD_BAR_WORDS 3456
#define XB_SPIN_CAP (1u << 18)

__device__ __forceinline__ unsigned xb_ld(unsigned* p)              { return __hip_atomic_load(p, __ATOMIC_RELAXED, __HIP_MEMORY_SCOPE_AGENT); }
__device__ __forceinline__ unsigned xb_add(unsigned* p, unsigned v) { return __hip_atomic_fetch_add(p, v, __ATOMIC_RELAXED, __HIP_MEMORY_SCOPE_AGENT); }
__device__ __forceinline__ unsigned xb_xcc_id() { return (unsigned)__builtin_amdgcn_s_getreg((3 << 11) | 20) & 0xFu; }
#define XB_SPIN(cond, bar) do { unsigned _sp = 0; while (cond) { __builtin_amdgcn_s_sleep(1); \
    if ((++_sp & 255u) == 0u) { if (xb_ld(&(bar)[XB_TMO])) break; if (_sp > XB_SPIN_CAP) { atomicAdd(&(bar)[XB_TMO], 1u); break; } } } } while (0)

struct XcdBarrier {
    unsigned* bar; unsigned x;
    volatile LAS unsigned* st;
};

__device__ __forceinline__ XcdBarrier xcd_barrier_post(unsigned* bar, volatile LAS unsigned* st) {
    XcdBarrier b; b.bar = bar; b.x = xb_xcc_id(); b.st = st;
    if (threadIdx.x == 0) (void)xb_add(&bar[XB_XCNT(b.x)], 1u);
    return b;
}
__device__ __forceinline__ void xcd_barrier_complete(unsigned* bar, unsigned x, unsigned& nloc, unsigned& nx) {
    const unsigned G = gridDim.x * gridDim.y * gridDim.z;
    unsigned sum, cnt, mine, sp = 0u;
    for (;;) {
        sum = 0u; cnt = 0u; mine = 0u;
#pragma unroll
        for (unsigned j = 0; j < 16; ++j) { const unsigned c = xb_ld(&bar[XB_XCNT(j)]); sum += c; cnt += (c > 0u) ? 1u : 0u; mine = (j == x) ? c : mine; }
        if (sum == G) break;
        __builtin_amdgcn_s_sleep(1);
        if ((++sp & 255u) == 0u) { if (xb_ld(&bar[XB_TMO])) break; if (sp > XB_SPIN_CAP) { atomicAdd(&bar[XB_TMO], 1u); break; } }
    }
    nloc = mine > 0u ? mine : 1u; nx = cnt > 0u ? cnt : 1u;
}

__device__ __forceinline__ void xcd_barrier(const XcdBarrier& b) {
    asm volatile("s_waitcnt vmcnt(0)" ::: "memory");
    __syncthreads();
    if (threadIdx.x == 0) {
        unsigned* bar = b.bar;
        __builtin_amdgcn_s_waitcnt(0);
        unsigned nloc = b.st[0], nx = b.st[1];
        if (nloc == 0u) { xcd_barrier_complete(bar, b.x, nloc, nx); b.st[0] = nloc; b.st[1] = nx; }
        const unsigned old = xb_add(&bar[XB_XSUB(b.x)], 1u);
        const unsigned gen = old / nloc;
        if (old + 1u == (gen + 1u) * nloc) {
            __builtin_amdgcn_fence(__ATOMIC_RELEASE, "agent");
            asm volatile("s_waitcnt vmcnt(0)" ::: "memory");
            const unsigned og = xb_add(&bar[XB_TOP], 1u);
            const unsigned tg = og / nx;
            if (og + 1u == (tg + 1u) * nx) xb_add(&bar[XB_TOPGEN], 1u);
            else XB_SPIN(xb_ld(&bar[XB_TOPGEN]) == tg, bar);
            __builtin_amdgcn_fence(__ATOMIC_ACQUIRE, "agent");
            xb_add(&bar[XB_XGEN(b.x)], 1u);
            asm volatile("s_waitcnt vmcnt(0)" ::: "memory");
        } else {
            XB_SPIN(xb_ld(&bar[XB_XGEN(b.x)]) == gen, bar);
            __builtin_amdgcn_fence(__ATOMIC_ACQUIRE, "agent");
            asm volatile("s_waitcnt vmcnt(0)" ::: "memory");
        }
    }
    __syncthreads();
}

constexpr unsigned long long FLAG_TOKEN = 0x5EA70B0A7C0FFEE1ull, FLAG_CLOSED = 0xC105EDC105EDC105ull;
__device__ __forceinline__ void flag_barrier(unsigned long long* slots, unsigned G, unsigned me) {
    asm volatile("s_waitcnt vmcnt(0)" ::: "memory");
    __syncthreads();
    if (threadIdx.x < 64) {
        if (threadIdx.x == 0) { __builtin_amdgcn_fence(__ATOMIC_RELEASE, "agent"); asm volatile("s_waitcnt vmcnt(0)" ::: "memory");
            __hip_atomic_store(slots + me, FLAG_TOKEN, __ATOMIC_RELAXED, __HIP_MEMORY_SCOPE_AGENT); }
        unsigned sp = 0;
        for (;;) { bool ok = true;
            for (unsigned i = threadIdx.x; i < G; i += 64) ok = ok && (__hip_atomic_load(slots + i, __ATOMIC_RELAXED, __HIP_MEMORY_SCOPE_AGENT) == FLAG_TOKEN);
            if (__all(ok)) break;
            __builtin_amdgcn_s_sleep(2); if (++sp > (1u << 20)) break; }
        __builtin_amdgcn_fence(__ATOMIC_ACQUIRE, "agent"); asm volatile("s_waitcnt vmcnt(0)" ::: "memory");
    }
    __syncthreads();
}
template <int W> __device__ __forceinline__ void pool_item(const bfu* u, bfu* pooled, int tb) {
    v4u r[W + 7];
#pragma unroll
    for (int j = 0; j < W + 7; ++j) { const int t = tb - (W - 1) + j; r[j] = (t >= 0) ? *(const v4u*)(u + (size_t)t * 1024) : (v4u){0u, 0u, 0u, 0u}; }
    float a[8];
#pragma unroll
    for (int e = 0; e < 8; ++e) a[e] = 0.f;
#pragma unroll
    for (int j = 0; j < W - 1; ++j) { a[0] += pg8::bf_lo(r[j].x); a[1] += pg8::bf_hi(r[j].x); a[2] += pg8::bf_lo(r[j].y); a[3] += pg8::bf_hi(r[j].y); a[4] += pg8::bf_lo(r[j].z); a[5] += pg8::bf_hi(r[j].z); a[6] += pg8::bf_lo(r[j].w); a[7] += pg8::bf_hi(r[j].w); }
#pragma unroll
    for (int k = 0; k < 8; ++k) {
        const v4u c = r[W - 1 + k]; const int t = tb + k;
        const float cv[8] = {pg8::bf_lo(c.x), pg8::bf_hi(c.x), pg8::bf_lo(c.y), pg8::bf_hi(c.y), pg8::bf_lo(c.z), pg8::bf_hi(c.z), pg8::bf_lo(c.w), pg8::bf_hi(c.w)};
#pragma unroll
        for (int e = 0; e < 8; ++e) a[e] += cv[e];
        const float inv = 1.f / (float)((t + 1) < W ? (t + 1) : W);
        v4u o; o.x = pk2(a[0] * inv - cv[0], a[1] * inv - cv[1]); o.y = pk2(a[2] * inv - cv[2], a[3] * inv - cv[3]); o.z = pk2(a[4] * inv - cv[4], a[5] * inv - cv[5]); o.w = pk2(a[6] * inv - cv[6], a[7] * inv - cv[7]);
        *(v4u*)(pooled + (size_t)t * 2048) = o;
        const v4u d = r[k];
        a[0] -= pg8::bf_lo(d.x); a[1] -= pg8::bf_hi(d.x); a[2] -= pg8::bf_lo(d.y); a[3] -= pg8::bf_hi(d.y); a[4] -= pg8::bf_lo(d.z); a[5] -= pg8::bf_hi(d.z); a[6] -= pg8::bf_lo(d.w); a[7] -= pg8::bf_hi(d.w);
    }
}
__device__ __forceinline__ void* ldp(LAS unsigned long long* tbl, int i) { const unsigned long long v = tbl[i];
    const unsigned lo = __builtin_amdgcn_readfirstlane((unsigned)v), hi = __builtin_amdgcn_readfirstlane((unsigned)(v >> 32)); return (void*)(((unsigned long long)hi << 32) | lo); }
struct Args { const float* in[21]; float* out; unsigned char* ws; int use_cg_sync; int pad; };

__global__ void __launch_bounds__(NWAVES * 64, 2) fwd_megakernel(Args args) {
    extern __shared__ __attribute__((aligned(16))) unsigned char lds[];
    LAS unsigned char* ldsp = (LAS unsigned char*)lds;
    const int G = gridDim.x, bx = blockIdx.x;
    const int vcu = (G % 8 == 0) ? (bx % 8) * (G / 8) + bx / 8 : bx;
    const int NGW = G * NWAVES, NGT = G * NWAVES * 64;
#define PHASE_IDS int tid = threadIdx.x; asm volatile("" : "+v"(tid)); const int lane = tid & 63, wave = __builtin_amdgcn_readfirstlane(tid >> 6); const int gw = vcu * NWAVES + wave, gt = bx * (NWAVES * 64) + tid; (void)lane; (void)gw; (void)gt
    LAS unsigned long long* ptab = (LAS unsigned long long*)(ldsp + 131072);
    if (threadIdx.x < 2) ((LAS unsigned*)(ldsp + 131072 + 768))[threadIdx.x] = 0u;
    if (threadIdx.x == 0) {
        ptab[0] = (unsigned long long)args.in[0]; ptab[1] = (unsigned long long)args.in[1]; ptab[2] = (unsigned long long)args.in[2]; ptab[3] = (unsigned long long)args.in[3];
        ptab[4] = (unsigned long long)args.in[4]; ptab[5] = (unsigned long long)args.in[5]; ptab[6] = (unsigned long long)args.in[6]; ptab[7] = (unsigned long long)args.in[7];
        ptab[8] = (unsigned long long)args.in[8]; ptab[9] = (unsigned long long)args.in[9]; ptab[10] = (unsigned long long)args.in[10]; ptab[11] = (unsigned long long)args.in[11];
        ptab[12] = (unsigned long long)args.in[12]; ptab[13] = (unsigned long long)args.in[13]; ptab[14] = (unsigned long long)args.in[14]; ptab[15] = (unsigned long long)args.in[15];
        ptab[16] = (unsigned long long)args.in[16]; ptab[17] = (unsigned long long)args.in[17]; ptab[18] = (unsigned long long)args.in[18]; ptab[19] = (unsigned long long)args.in[19];
        ptab[20] = (unsigned long long)args.in[20]; ptab[21] = (unsigned long long)args.out; ptab[22] = (unsigned long long)args.ws;
    }
    __syncthreads();
    if (args.use_cg_sync) cg::this_grid().sync();
#define GRID_BAR() do { XcdBarrier b_; b_.bar = (unsigned*)(WSB + WS_BAR); b_.x = xb_xcc_id(); b_.st = (volatile LAS unsigned*)(ldsp + 131072 + 768); xcd_barrier(b_); } while (0)
#define INP(i) ((const float*)ldp(ptab, (i)))
#define OUTP ((float*)ldp(ptab, 21))
#define WSB ((unsigned char*)ldp(ptab, 22))
#define WSP(T, off) ((T*)(ws + (off)))
#define DEF_WS unsigned char* ws = WSB
    {
        PHASE_IDS; DEF_WS; LAS float* scr = (LAS float*)(ldsp + wave * 16384); const float* x = INP(0); const float* p = INP(1); const float* norm_mix_g = INP(2); const float* w_in = INP(3); const float* pool_grp_w = INP(9); const float* pool_scale = INP(10);
        const float* w_attn_br = INP(11); const float* w_pool_br = INP(12); const float* w_out = INP(13); const float* norm_mlp_g = INP(14); const float* w_up = INP(15); const float* w_dn = INP(16);
        const float* norm_ple_g = INP(17); const float* w_ple = INP(18); const float* w_pg = INP(19);
        float* ss1 = WSP(float, WS_SS); bfu* WIN = WSP(bfu, WS_WIN); bfu* WUP = WSP(bfu, WS_WUP); bfu* WDN = WSP(bfu, WS_WDN); bfu* WOUT = WSP(bfu, WS_WOUT); bfu* WPG = WSP(bfu, WS_WPG);
        bfu* WBR = WSP(bfu, WS_WBR); bfu* WPB = WSP(bfu, WS_WPB); bfu* WPLE = WSP(bfu, WS_WPLE); bfu* PGW = WSP(bfu, WS_PGW); bfu* PB = WSP(bfu, WS_PB); bfu* HN = WSP(bfu, WS_HN);
        for (int rep_ = 0; rep_ < REP_P0; ++rep_) {
        constexpr int I_IN = (DM / 64) * (INW / 32), I_AB = (ATTW / 64) * (DM / 32), I_PB = I_AB;
        constexpr int NITEMS = I_IN + I_AB + I_PB;
        for (int it = gw; it < NITEMS; it += NGW) {
            int r = it;
            if (r < I_IN) { p0_transpose_item(w_in, DM, INW, WIN, nullptr, scr, r, lane); continue; } r -= I_IN;
            if (r < I_AB) { p0_transpose_item(w_attn_br, ATTW, DM, WBR, nullptr, scr, r, lane, 2048); continue; } r -= I_AB;
            p0_transpose_item(w_pool_br, ATTW, DM, WPB, pool_scale, scr, r, lane);
        }
        for (int i = gt; i < (4 * 256 * 256) / 4; i += NGT) { const f32x4 v = ((const f32x4*)pool_grp_w)[i]; ((uint2*)PGW)[i] = make_uint2(pk2(v[0], v[1]), pk2(v[2], v[3])); }
        for (int i = gt; i < 3 * S + 128; i += NGT) ss1[i] = 0.f;
        for (int i = gt; i < 4096; i += NGT) WSP(unsigned, WS_BAR)[i] = 0u;
        for (int m = gw; m < S; m += NGW) {
            const f32x4* xr = (const f32x4*)(x + (size_t)m * DM) + lane; f32x4 v[8]; float s = 0.f;
#pragma unroll
            for (int j = 0; j < 8; ++j) { v[j] = __builtin_nontemporal_load(xr + 64 * j); s += pg8::sq4(v[j]); }
            const float rs = 1.f / sqrtf(wave_sum(s) * (1.f / DM) + NORM_EPS);
            uint2* o8 = (uint2*)(HN + (size_t)m * DM) + lane;
#pragma unroll
            for (int j = 0; j < 8; ++j) { const f32x4 g = ((const f32x4*)norm_mix_g)[64 * j + lane]; o8[64 * j] = make_uint2(pk2(v[j][0] * rs * g[0], v[j][1] * rs * g[1]), pk2(v[j][2] * rs * g[2], v[j][3] * rs * g[3])); }
        }
        }
    }
    flag_barrier((unsigned long long*)(WSB + WS_FLAGS), gridDim.x, blockIdx.x);
    if (threadIdx.x == 0) (void)xb_add(&((unsigned*)(WSB + WS_BAR))[XB_XCNT(xb_xcc_id())], 1u);

    {
        PHASE_IDS; DEF_WS; bfu* HN = WSP(bfu, WS_HN); bfu* WIN = WSP(bfu, WS_WIN); bfu* Z = WSP(bfu, WS_Z); bfu* GT = WSP(bfu, WS_G); bfu* WPB = WSP(bfu, WS_WPB); bfu* PGW = WSP(bfu, WS_PGW); bfu* WBR = WSP(bfu, WS_WBR);
        pg8::Gemm g{HN, WIN, S, INW, DM, DM, DM, 0, 0}; pg8::StaticOrder so; so.init(S, INW, G, bx);
        pg8::EpiInProj E{Z, GT, QSCALE, (unsigned*)(WSP(float, WS_SS) + 3 * S)};
        for (int rep_ = 0; rep_ < REP_P1; ++rep_) pg8::gemm_phase<pg8::EpiInProj, pg8::StaticOrder, true, true>(ldsp, g, so, E);
    }
    GRID_BAR();

    {
        PHASE_IDS; DEF_WS; bfu* Z = WSP(bfu, WS_Z); bfu* Qb = Z; bfu* Kb = Z + (size_t)S * 1024; bfu* Vb = Z + (size_t)2 * S * 1024; bfu* Ub = Z + (size_t)3 * S * 1024;
        bfu* AB2 = WSP(bfu, WS_AB2); bfu* Obase = (bfu*)OUTP; float* Lbase = WSP(float, WS_SCR);
        { bfu* WPB = WSP(bfu, WS_WPB); bfu* PGW = WSP(bfu, WS_PGW); bfu* WBR = WSP(bfu, WS_WBR);
        pg8::Gemm g2{WPB, PGW, DM, 256, 256, 1024, 256, 256, 65536}; pg8::GroupOrder go{G, bx};
        pg8::EpiBf16G E2{WBR + 1024, 2048, 256};
        pg8::gemm_phase<pg8::EpiBf16G, pg8::GroupOrder, true, true>(ldsp, g2, go, E2);
        }
        __syncthreads();
        unsigned* nmax = (unsigned*)(WSP(float, WS_SS) + 3 * S); unsigned* qctr = nmax + 64;
        LAS unsigned* qw = (LAS unsigned*)(ldsp + 131072 + 512);
        for (int rep_ = 0; rep_ < REP_P2; ++rep_)
        for (;;) {
            if (threadIdx.x == 0) *qw = __hip_atomic_fetch_add(qctr + rep_, 1u, __ATOMIC_RELAXED, __HIP_MEMORY_SCOPE_AGENT);
            __syncthreads();
            const unsigned pidx = __builtin_amdgcn_readfirstlane(*qw);
            if (pidx >= 1152u) break;
            if (pidx < 512u && (pidx & 1u) == 1u) {
                const int ci = (int)(pidx >> 1);
                constexpr int J_UP = (DM / 64) * (FF / 32), J_DN = (FF / 64) * (DM / 32), J_OUT = (DM / 64) * (DM / 32), J_PG = J_OUT, J_PLE = (PLE / 64) * (DM / 32), J_ALL = J_UP + J_DN + J_OUT + J_PG + J_PLE;
                static_assert(J_ALL == 256 * 81, "conversion items");
#pragma unroll 1
                for (int k2 = 0; k2 < 11; ++k2) { const int wi = wave + 8 * k2; if (wi >= 81) break; int r = ci * 81 + wi;
                    if (r < J_UP) { p0_transpose_item(INP(15), DM, FF, WSP(bfu, WS_WUP), INP(14), nullptr, r, lane); continue; } r -= J_UP;
                    if (r < J_DN) { p0_transpose_item(INP(16), FF, DM, WSP(bfu, WS_WDN), nullptr, nullptr, r, lane); continue; } r -= J_DN;
                    if (r < J_OUT) { p0_transpose_item(INP(13), DM, DM, WSP(bfu, WS_WOUT), nullptr, nullptr, r, lane); continue; } r -= J_OUT;
                    if (r < J_PG) { p0_transpose_item(INP(19), DM, DM, WSP(bfu, WS_WPG), INP(17), nullptr, r, lane); continue; } r -= J_PG;
                    p0_transpose_item(INP(18), PLE, DM, WSP(bfu, WS_WPLE), nullptr, nullptr, r, lane); }
                { const f32x4* p4 = (const f32x4*)INP(1); uint2* pb = (uint2*)WSP(bfu, WS_PB);
#pragma unroll
                  for (int k2 = 0; k2 < 4; ++k2) { const int i = ci * 2048 + k2 * 512 + (int)threadIdx.x; const f32x4 v = __builtin_nontemporal_load(p4 + i); pb[i] = make_uint2(pk2(v[0], v[1]), pk2(v[2], v[3])); } }
                __syncthreads(); continue; }
            const unsigned n = (pidx < 512u) ? (pidx >> 1) : pidx - 256u;
            if (n >= 768u) {
                const int pc = (int)(n - 768u);
#pragma unroll 1
                for (int k2 = 0; k2 < 2; ++k2) { const int i = pc * 1024 + k2 * 512 + (int)threadIdx.x; const int ch = i & 127, tb = (i >> 7) * 8, gidx = ch >> 5;
                    const bfu* up = Ub + ch * 8; bfu* pp = AB2 + 1024 + ch * 8;
                    if (gidx == 0) pool_item<2>(up, pp, tb); else if (gidx == 1) pool_item<4>(up, pp, tb); else if (gidx == 2) pool_item<8>(up, pp, tb); else pool_item<16>(up, pp, tb); }
                __syncthreads(); continue; }
            int qb, part, c_, h_; bool may_split;
            if (n < 512u) { qb = 31 - (int)(n >> 4); part = (int)((n >> 3) & 1u); c_ = (int)((n >> 2) & 1u); h_ = 4 + (int)(n & 3u); may_split = true; }
            else { const unsigned m_ = n - 512u; qb = 31 - (int)(m_ >> 3); part = 0; c_ = (int)((m_ >> 2) & 1u); h_ = (int)(m_ & 3u); may_split = false; }
            const int hq = c_ * 8 + h_;
            const float slope2 = __builtin_exp2f(-(float)(h_ + 1)) * 1.4426950408889634f;
            const float qa = __uint_as_float(__hip_atomic_load(nmax + hq * 2, __ATOMIC_RELAXED, __HIP_MEMORY_SCOPE_AGENT)), qc = __uint_as_float(__hip_atomic_load(nmax + hq * 2 + 1, __ATOMIC_RELAXED, __HIP_MEMORY_SCOPE_AGENT));
            const float ka = __uint_as_float(__hip_atomic_load(nmax + (16 + hq) * 2, __ATOMIC_RELAXED, __HIP_MEMORY_SCOPE_AGENT)), kc = __uint_as_float(__hip_atomic_load(nmax + (16 + hq) * 2 + 1, __ATOMIC_RELAXED, __HIP_MEMORY_SCOPE_AGENT));
            const float bt = sqrtf((qa + qc) * (ka + kc)) * 1.02f + 0.01f;
            const float dmin = fminf(ceilf((2.f * bt + 32.f - __builtin_log2f(1.f - __builtin_exp2f(-slope2))) / slope2), 1048576.f);
            int t0 = (qb * 256 - (int)dmin + 1); t0 = t0 > 0 ? (t0 >> 6) & ~1 : 0;
            t0 = __builtin_amdgcn_readfirstlane(t0);
            const float bref = __uint_as_float(__builtin_amdgcn_readfirstlane(__float_as_uint(fminf(bt, 60.f))));
            const int nt_all = 4 * qb + 4 - t0; const bool split = may_split && nt_all >= ATT_SPLIT_MIN; const int na = split ? (((nt_all >> 1) + 1) & ~1) : nt_all;
            if (part == 1 && !split) { __syncthreads(); continue; }
            attn_body::bf16* Od = (attn_body::bf16*)(Obase + (size_t)(c_ * 2 + part) * S * 1024); float* Ld = Lbase + (size_t)(c_ * 2 + part) * S * 8 + h_;
            if (part == 0 && !split && threadIdx.x < 256) Lbase[((size_t)(c_ * 2 + 1) * S + qb * 256 + threadIdx.x) * 8 + h_] = 0.f;
            if (part == 0) attn_body::attn_unit<8>(hq, 2 * h_, qb, (const attn_body::bf16*)Qb, (const attn_body::bf16*)Kb, (const attn_body::bf16*)Vb, Od, slope2, t0, na, !split, Ld, bref, (char*)lds);
            else attn_body::attn_unit<8>(hq, 2 * h_, qb, (const attn_body::bf16*)Qb, (const attn_body::bf16*)Kb, (const attn_body::bf16*)Vb, Od, slope2, t0 + na, nt_all - na, true, Ld, bref, (char*)lds);
        }
    }
    GRID_BAR();

    {
        PHASE_IDS; DEF_WS; const float* lq1 = INP(4); const float* lk1 = INP(5); const float* lq2 = INP(6); const float* lk2 = INP(7); const float* subln_g = INP(8);
        bfu* Obase = (bfu*)OUTP; const float* Lbase = WSP(float, WS_SCR); bfu* AB2 = WSP(bfu, WS_AB2);
        const float d1 = wave_sum(lq1[lane] * lk1[lane]), d2 = wave_sum(lq2[lane] * lk2[lane]);
        const float lam = expf(d1) - expf(d2) + LAM_INIT;
        f32x4 sg[4];
#pragma unroll
        for (int j = 0; j < 4; ++j) sg[j] = ((const f32x4*)subln_g)[(lane & 7) * 4 + j] * (1.f - LAM_INIT);
        for (int m = gw; m < S; m += NGW) {
            float wgt[4];
#pragma unroll
            for (int cp = 0; cp < 4; ++cp) wgt[cp] = Lbase[((size_t)cp * S + m) * 8 + (lane >> 3)];
            const float i1 = 1.f / (wgt[0] + wgt[1]), i2 = 1.f / (wgt[2] + wgt[3]);
            const float w1a = wgt[0] * i1, w1b = wgt[1] * i1, w2a = -lam * wgt[2] * i2, w2b = -lam * wgt[3] * i2;
            const v4u* pa1 = (const v4u*)(Obase + ((size_t)0 * S + m) * 1024 + lane * 16); const v4u* pb1 = (const v4u*)(Obase + ((size_t)1 * S + m) * 1024 + lane * 16);
            const v4u* pa2 = (const v4u*)(Obase + ((size_t)2 * S + m) * 1024 + lane * 16); const v4u* pb2 = (const v4u*)(Obase + ((size_t)3 * S + m) * 1024 + lane * 16);
            f32x4 d[4]; float s = 0.f;
#pragma unroll
            for (int j = 0; j < 2; ++j) { f32x4 x0, x1, acc0 = (f32x4){0.f, 0.f, 0.f, 0.f}, acc1 = acc0;
                if (wgt[0] > 0.f) { pg8::unpack8(pa1[j], x0, x1); acc0 += x0 * w1a; acc1 += x1 * w1a; }
                if (wgt[1] > 0.f) { pg8::unpack8(pb1[j], x0, x1); acc0 += x0 * w1b; acc1 += x1 * w1b; }
                if (wgt[2] > 0.f) { pg8::unpack8(pa2[j], x0, x1); acc0 += x0 * w2a; acc1 += x1 * w2a; }
                if (wgt[3] > 0.f) { pg8::unpack8(pb2[j], x0, x1); acc0 += x0 * w2b; acc1 += x1 * w2b; }
                d[2 * j] = acc0; d[2 * j + 1] = acc1; s += pg8::sq4(acc0) + pg8::sq4(acc1); }
            s += __shfl_xor(s, 1); s += __shfl_xor(s, 2); s += __shfl_xor(s, 4);
            const float rs = 1.f / sqrtf(s * (1.f / 128.f) + NORM_EPS);
            v4u* o = (v4u*)(AB2 + (size_t)m * 2048 + lane * 16);
#pragma unroll
            for (int j = 0; j < 2; ++j) { const f32x4 v0 = d[2 * j] * rs * sg[2 * j], v1 = d[2 * j + 1] * rs * sg[2 * j + 1];
                v4u w; w.x = pk2(v0[0], v0[1]); w.y = pk2(v0[2], v0[3]); w.z = pk2(v1[0], v1[1]); w.w = pk2(v1[2], v1[3]); o[j] = w; }
        }
    }
    GRID_BAR();

    {
        PHASE_IDS; DEF_WS; bfu* AB2 = WSP(bfu, WS_AB2); bfu* WBR = WSP(bfu, WS_WBR); bfu* MG = WSP(bfu, WS_MG); bfu* GA = WSP(bfu, WS_G); bfu* GP = GA + (size_t)S * 2048;
        pg8::StaticOrder so; so.init(S, DM, G, bx);
        pg8::Gemm g1{AB2, WBR, S, DM, DM, DM, DM, 0, 0}; pg8::EpiMerged E1{GA, GP, MG};
        for (int rep_ = 0; rep_ < REP_P3; ++rep_) pg8::gemm_phase<pg8::EpiMerged, pg8::StaticOrder, true, true>(ldsp, g1, so, E1);
    }
    GRID_BAR();

    {
        PHASE_IDS; DEF_WS; float* out = OUTP; const float* x = INP(0); bfu* MG = WSP(bfu, WS_MG); bfu* WOUT = WSP(bfu, WS_WOUT); bfu* XB = WSP(bfu, WS_XB); float* ss1 = WSP(float, WS_SS);
        pg8::StaticOrder so; so.init(S, DM, G, bx);
        pg8::Gemm g1{MG, WOUT, S, DM, DM, DM, DM, 0, 0}; pg8::EpiResid<false> E1{x, XB, ss1};
        pg8::gemm_phase<pg8::EpiResid<false>, pg8::StaticOrder, true, true>(ldsp, g1, so, E1);
        for (int rep_ = 1; rep_ < REP_P4; ++rep_) { pg8::EpiResid<false> ER{x, XB, (float*)(ws + WS_BAR + 131072)}; pg8::gemm_phase<pg8::EpiResid<false>, pg8::StaticOrder, true, true>(ldsp, g1, so, ER); }
        for (int rep_ = 0; rep_ < REP_G4; ++rep_) { pg8::EpiDummy ED{WSP(bfu, WS_SCR)}; pg8::gemm_phase<pg8::EpiDummy, pg8::StaticOrder, true, true>(ldsp, g1, so, ED); }
    }
    GRID_BAR();

    {
        PHASE_IDS; DEF_WS; bfu* XB = WSP(bfu, WS_XB); bfu* WUP = WSP(bfu, WS_WUP); bfu* HB = WSP(bfu, WS_H); float* ss1 = WSP(float, WS_SS);
        pg8::StaticOrder so; so.init(S, FF, G, bx);
        pg8::Gemm g1{XB, WUP, S, FF, DM, DM, DM, 0, 0}; pg8::EpiUp E1{HB, ss1};
        for (int rep_ = 0; rep_ < REP_P5; ++rep_) pg8::gemm_phase<pg8::EpiUp, pg8::StaticOrder, true, true>(ldsp, g1, so, E1);
    }
    GRID_BAR();

    {
        PHASE_IDS; DEF_WS; float* out = OUTP; bfu* HB = WSP(bfu, WS_H); bfu* WDN = WSP(bfu, WS_WDN); bfu* XB = WSP(bfu, WS_XB); float* ss2 = WSP(float, WS_SS) + S;
        pg8::StaticOrder so; so.init(S, DM, G, bx);
        pg8::Gemm g1{HB, WDN, S, DM, FF, FF, FF, 0, 0}; pg8::EpiResid<true> E1{XB, XB, ss2};
        pg8::gemm_phase<pg8::EpiResid<true>, pg8::StaticOrder, true, true>(ldsp, g1, so, E1);
        for (int rep_ = 0; rep_ < REP_G6; ++rep_) { pg8::EpiDummy ED{WSP(bfu, WS_SCR)}; pg8::gemm_phase<pg8::EpiDummy, pg8::StaticOrder, true, true>(ldsp, g1, so, ED); }
    }
    GRID_BAR();

    {
        PHASE_IDS; DEF_WS; float* out = OUTP; bfu* PB = WSP(bfu, WS_PB); bfu* WPLE = WSP(bfu, WS_WPLE); bfu* PE = WSP(bfu, WS_PE); bfu* XB = WSP(bfu, WS_XB); bfu* WPG = WSP(bfu, WS_WPG);
        float* ss2 = WSP(float, WS_SS) + S; float* ss3 = ss2 + S;
        pg8::StaticOrder so; so.init(S, DM, G, bx);
        pg8::Gemm g1{PB, WPLE, S, DM, PLE, PLE, PLE, 0, 0}; pg8::EpiStoreBf16 E1{PE};
        pg8::gemm_phase<pg8::EpiStoreBf16, pg8::StaticOrder, true, true>(ldsp, g1, so, E1);
        pg8::Gemm g2{XB, WPG, S, DM, DM, DM, DM, 0, 0}; pg8::EpiPleGateFinal E2{PE, XB, out, ss2, ss3, (unsigned*)(WSP(float, WS_SS) + 3 * S) + 96, INP(20)};
        pg8::gemm_phase<pg8::EpiPleGateFinal, pg8::StaticOrder, false, true>(ldsp, g2, so, E2);
    }

    if (threadIdx.x == 0) __hip_atomic_store((unsigned long long*)(WSB + WS_FLAGS) + blockIdx.x, FLAG_CLOSED, __ATOMIC_RELAXED, __HIP_MEMORY_SCOPE_AGENT);
}

extern "C" void kernel_launch(void* const* d_in, const int* in_sizes, int n_in, void* d_out, int out_size, void* d_ws, size_t ws_size, hipStream_t stream) {
    static int grid_blocks = 0;
    if (grid_blocks == 0) {
        if (n_in != 21 || in_sizes[0] != S * DM || out_size != S * DM || ws_size < WS_END) { fprintf(stderr, "kernel_launch: unexpected shapes (n_in %d, in0 %d, out %d, ws %zu); nothing launched\n", n_in, n_in > 0 ? in_sizes[0] : -1, out_size, ws_size); grid_blocks = -1; return; }
        int dev = 0, cus = 0, per_cu = 0;
        (void)hipGetDevice(&dev); (void)hipDeviceGetAttribute(&cus, hipDeviceAttributeMultiprocessorCount, dev);
        if (hipFuncSetAttribute((const void*)fwd_megakernel, hipFuncAttributeMaxDynamicSharedMemorySize, LDS_BYTES) != hipSuccess) { fprintf(stderr, "kernel_launch: hipFuncSetAttribute failed\n"); grid_blocks = -1; return; }
        if (hipOccupancyMaxActiveBlocksPerMultiprocessor(&per_cu, (const void*)fwd_megakernel, NWAVES * 64, LDS_BYTES) != hipSuccess || per_cu < 1) { fprintf(stderr, "kernel_launch: occupancy query says %d\n", per_cu); per_cu = 1; }
        (void)hipGetLastError();
        grid_blocks = cus * 1;
        fprintf(stderr, "kernel_launch: cus %d per_cu %d grid %d\n", cus, per_cu, grid_blocks);
    }
    if (grid_blocks < 0) return;
    Args a{};
    for (int i = 0; i < 21; ++i) a.in[i] = (const float*)d_in[i];
    a.out = (float*)d_out; a.ws = (unsigned char*)d_ws;
    void* kargs[] = {&a};
    hipError_t e = hipLaunchCooperativeKernel((const void*)fwd_megakernel, dim3(grid_blocks), dim3(NWAVES * 64), kargs, LDS_BYTES, stream);
    if (e != hipSuccess) fprintf(stderr, "cooperative launch failed: %s (grid %d)\n", hipGetErrorString(e), grid_blocks);
}
```

```cpp
#include <hip/hip_runtime.h>
#include <hip/hip_cooperative_groups.h>
#include <cstdio>
#include <cstdint>
namespace cg = cooperative_groups;

namespace pg8 {
#define PG8_LAS __attribute__((address_space(3)))
typedef unsigned short bf16_t;
typedef short bf16x8 __attribute__((ext_vector_type(8)));
typedef float f32x4 __attribute__((ext_vector_type(4)));
typedef unsigned u32x4 __attribute__((ext_vector_type(4)));
constexpr int BM = 256, BK = 64, HALF = 128, HTB = HALF * BK * 2  , STAGE_BYTES = 8 * HTB, NXCD = 8, WGM = 8;

__host__ __device__ __forceinline__ int lds_byte(int r, int c) { const int st = (r >> 4) * 2 + (c >> 5), rr = r & 15, cc = c & 31, ob = rr * 64 + cc * 2; return st * 1024 + (ob ^ (((ob >> 9) & 1) << 5)); }
__host__ __device__ __forceinline__ void stage_rc(int b, int& R, int& C) { const int st = b / 1024, sb = b % 1024, swz = sb ^ (((sb >> 9) & 1) << 5); R = (st >> 1) * 16 + swz / 64; C = (st & 1) * 32 + (swz % 64) / 2; }
__host__ __device__ __forceinline__ int perm32(int rho) { const int n = rho >> 4, i = rho & 15; return 8 * (i >> 2) + 4 * n + (i & 3); }

struct Unit { int pm, pn, g; };
struct Gemm { const bf16_t* A; const bf16_t* Bt; int M, N, K, lda, ldb; size_t gsA, gsB; };

struct StaticOrder {
    int nM, nN, nwg, G, c;
    __host__ __device__ void init(int M, int N, int G_, int c_) { nM = M / BM; nN = N / BM; nwg = nM * nN; G = G_; c = c_; }
    __host__ __device__ bool next(int i, Unit& u) const {
        const long L = (long)i * G + c; if (L >= nwg) return false;
        int wgid = (int)L; { const int q = nwg / NXCD, r = nwg % NXCD, xcd = wgid % NXCD, off = wgid / NXCD; wgid = (xcd < r ? xcd * (q + 1) : r * (q + 1) + (xcd - r) * q) + off; }
        const int nig = WGM * nN, gid = wgid / nig, fm = gid * WGM, gsz = (nM - fm) < WGM ? (nM - fm) : WGM;
        u.pm = fm + ((wgid % nig) % gsz); u.pn = (wgid % nig) / gsz; u.g = 0; return true;
    }
    __device__ __forceinline__ void a_ready(const Unit&) const {}
    __device__ __forceinline__ void done(const Unit&) const {}
};

__device__ __forceinline__ unsigned cvt_pk_bf16(float lo, float hi) { unsigned r; asm volatile("v_cvt_pk_bf16_f32 %0, %1, %2" : "=v"(r) : "v"(lo), "v"(hi)); return r; }
typedef unsigned u32x2 __attribute__((ext_vector_type(2)));
__device__ __forceinline__ float bf_lo(unsigned w) { return __uint_as_float(w << 16); }
__device__ __forceinline__ float bf_hi(unsigned w) { return __uint_as_float(w & 0xffff0000u); }
__device__ __forceinline__ float sigm(float v) { return __builtin_amdgcn_rcpf(1.f + __builtin_amdgcn_exp2f(-1.4426950408889634f * v)); }
__device__ __forceinline__ u32x4 pack8(const f32x4& v0, const f32x4& v1) { u32x4 w; w.x = cvt_pk_bf16(v0[0], v0[1]); w.y = cvt_pk_bf16(v0[2], v0[3]); w.z = cvt_pk_bf16(v1[0], v1[1]); w.w = cvt_pk_bf16(v1[2], v1[3]); return w; }
__device__ __forceinline__ void unpack8(const u32x4& g, f32x4& a, f32x4& b) { a = (f32x4){bf_lo(g.x), bf_hi(g.x), bf_lo(g.y), bf_hi(g.y)}; b = (f32x4){bf_lo(g.z), bf_hi(g.z), bf_lo(g.w), bf_hi(g.w)}; }
__device__ __forceinline__ float sq4(const f32x4& v) { return (v[0] * v[0] + v[1] * v[1]) + (v[2] * v[2] + v[3] * v[3]); }
constexpr int SEQ_ = 8192;
#define EPI_LOOP_ROWS _Pragma("unroll") for (int ai = 0; ai < 2; ++ai) _Pragma("unroll") for (int m = 0; m < 4; ++m)
#define EPI_LOOP_BJ _Pragma("unroll") for (int bj = 0; bj < 2; ++bj)

struct EpiInProj { static constexpr bool PERM = true, AFTER_DRAIN = false, MIDK = false;
    bf16_t* Z; bf16_t* G; float qscale; unsigned* nmax;
    __device__ __forceinline__ void operator()(const f32x4 (&acc)[2][2][4][2], const Unit& u, int wr, int wc, int fr, int fq) const {
        const int colt = u.pn * BM, reg = colt >> 10; const bool sig = reg >= 4;
        bf16_t* base; int ldc, c0; float sc = 1.f;
        if (!sig) { base = Z + (size_t)reg * ((size_t)SEQ_ * 1024); ldc = 1024; c0 = colt & 1023; if (reg == 0) sc = qscale; }
        else { const int gi = (reg - 4) >> 1; base = G + (size_t)gi * ((size_t)SEQ_ * 2048); ldc = 2048; c0 = colt - 4096 - gi * 2048; }
        const int col0 = c0 + wc * 32 + 8 * fq, row0 = u.pm * BM + wr * 64 + fr;
        float mx[2] = {0.f, 0.f};
        EPI_LOOP_ROWS { bf16_t* rowp = base + (size_t)(row0 + ai * HALF + m * 16) * ldc + col0;
            EPI_LOOP_BJ { f32x4 v0 = acc[ai][bj][m][0], v1 = acc[ai][bj][m][1];
                if (sig) {
#pragma unroll
                    for (int i = 0; i < 4; ++i) { v0[i] = sigm(v0[i]); v1[i] = sigm(v1[i]); } }
                else { v0 = v0 * sc; v1 = v1 * sc; }
                if (reg <= 1) { float s = sq4(v0) + sq4(v1); s += __shfl_xor(s, 16); s += __shfl_xor(s, 32); mx[bj] = fmaxf(mx[bj], s); }
                *(u32x4*)(rowp + bj * HALF) = pack8(v0, v1); } }
        if (reg <= 1) {
            EPI_LOOP_BJ { float v = mx[bj]; v = fmaxf(v, __shfl_xor(v, 1)); v = fmaxf(v, __shfl_xor(v, 2)); v = fmaxf(v, __shfl_xor(v, 4)); v = fmaxf(v, __shfl_xor(v, 8));
                const int cg_ = c0 + bj * HALF + wc * 32;
                if (fr == 0 && fq == 0) atomicMax(nmax + (reg * 16 + (cg_ >> 6)) * 2 + ((cg_ >> 5) & 1), __float_as_uint(v)); }
        }
    }
};
struct EpiBf16G { static constexpr bool PERM = true, AFTER_DRAIN = false, MIDK = false;
    bf16_t* O; int ldc; int gcols;
    __device__ __forceinline__ void operator()(const f32x4 (&acc)[2][2][4][2], const Unit& u, int wr, int wc, int fr, int fq) const {
        const int col0 = u.g * gcols + u.pn * BM + wc * 32 + 8 * fq, row0 = u.pm * BM + wr * 64 + fr;
        EPI_LOOP_ROWS { bf16_t* rowp = O + (size_t)(row0 + ai * HALF + m * 16) * ldc + col0;
            EPI_LOOP_BJ { *(u32x4*)(rowp + bj * HALF) = pack8(acc[ai][bj][m][0], acc[ai][bj][m][1]); } }
    }
};
struct EpiGateA { static constexpr bool PERM = true, AFTER_DRAIN = false, MIDK = false;
    const bf16_t* GA; bf16_t* T;
    __device__ __forceinline__ void operator()(const f32x4 (&acc)[2][2][4][2], const Unit& u, int wr, int wc, int fr, int fq) const {
        const int col0 = u.pn * BM + wc * 32 + 8 * fq, row0 = u.pm * BM + wr * 64 + fr;
        EPI_LOOP_ROWS { const size_t off = (size_t)(row0 + ai * HALF + m * 16) * 2048 + col0;
            EPI_LOOP_BJ { const u32x4 g = *(const u32x4*)(GA + off + bj * HALF); f32x4 g0, g1; unpack8(g, g0, g1);
                *(u32x4*)(T + off + bj * HALF) = pack8(acc[ai][bj][m][0] * g0, acc[ai][bj][m][1] * g1); } asm volatile("" ::: "memory"); }
    }
};
struct EpiGateP { static constexpr bool PERM = true, AFTER_DRAIN = false, MIDK = false;
    const bf16_t* GP; const bf16_t* T; bf16_t* MG;
    __device__ __forceinline__ void operator()(const f32x4 (&acc)[2][2][4][2], const Unit& u, int wr, int wc, int fr, int fq) const {
        const int col0 = u.pn * BM + wc * 32 + 8 * fq, row0 = u.pm * BM + wr * 64 + fr;
        EPI_LOOP_ROWS { const size_t off = (size_t)(row0 + ai * HALF + m * 16) * 2048 + col0;
            EPI_LOOP_BJ { const u32x4 g = *(const u32x4*)(GP + off + bj * HALF); f32x4 g0, g1; unpack8(g, g0, g1);
                const u32x4 tt = *(const u32x4*)(T + off + bj * HALF); f32x4 t0, t1; unpack8(tt, t0, t1);
                *(u32x4*)(MG + off + bj * HALF) = pack8(t0 + acc[ai][bj][m][0] * g0, t1 + acc[ai][bj][m][1] * g1); } asm volatile("" ::: "memory"); }
    }
};
template <bool BASE_BF16> struct EpiResid { static constexpr bool PERM = true, AFTER_DRAIN = false, MIDK = false;
    const void* base; bf16_t* outb; float* ss;
    __device__ __forceinline__ void operator()(const f32x4 (&acc)[2][2][4][2], const Unit& u, int wr, int wc, int fr, int fq) const {
        const int col0 = u.pn * BM + wc * 32 + 8 * fq, row0 = u.pm * BM + wr * 64 + fr;
        float sv[2][4];
        EPI_LOOP_ROWS { const int row = row0 + ai * HALF + m * 16; const size_t off = (size_t)row * 2048 + col0; float s = 0.f;
            EPI_LOOP_BJ { f32x4 b0, b1;
                if (BASE_BF16) { const u32x4 bb = *(const u32x4*)((const bf16_t*)base + off + bj * HALF); unpack8(bb, b0, b1); }
                else { b0 = __builtin_nontemporal_load((const f32x4*)((const float*)base + off + bj * HALF)); b1 = __builtin_nontemporal_load((const f32x4*)((const float*)base + off + bj * HALF + 4)); }
                const f32x4 o0 = b0 + acc[ai][bj][m][0], o1 = b1 + acc[ai][bj][m][1];
                *(u32x4*)(outb + off + bj * HALF) = pack8(o0, o1); s += sq4(o0) + sq4(o1); }
            s += __shfl_xor(s, 16); s += __shfl_xor(s, 32); sv[ai][m] = s; asm volatile("" ::: "memory"); }
#pragma unroll
        for (int ai = 0; ai < 2; ++ai) { const float t = fq == 0 ? sv[ai][0] : fq == 1 ? sv[ai][1] : fq == 2 ? sv[ai][2] : sv[ai][3]; unsafeAtomicAdd(ss + row0 + ai * HALF + fq * 16, t); }
    }
};
struct EpiUp { static constexpr bool PERM = true, AFTER_DRAIN = false, MIDK = false;
    bf16_t* H; const float* ss;
    __device__ __forceinline__ void operator()(const f32x4 (&acc)[2][2][4][2], const Unit& u, int wr, int wc, int fr, int fq) const {
        const int col0 = u.pn * BM + wc * 32 + 8 * fq, row0 = u.pm * BM + wr * 64 + fr;
        EPI_LOOP_ROWS { const int row = row0 + ai * HALF + m * 16; const float rs = __builtin_amdgcn_rsqf(ss[row] * (1.f / 2048.f) + 1e-6f);
            EPI_LOOP_BJ { f32x4 v0 = acc[ai][bj][m][0] * rs, v1 = acc[ai][bj][m][1] * rs;
#pragma unroll
                for (int i = 0; i < 4; ++i) { const float a = fmaxf(v0[i], 0.f), b = fmaxf(v1[i], 0.f); v0[i] = a * a; v1[i] = b * b; }
                *(u32x4*)(H + (size_t)row * 8192 + col0 + bj * HALF) = pack8(v0, v1); } }
    }
};
struct EpiStoreF32 { static constexpr bool PERM = true, AFTER_DRAIN = false, MIDK = false;
    float* out;
    __device__ __forceinline__ void operator()(const f32x4 (&acc)[2][2][4][2], const Unit& u, int wr, int wc, int fr, int fq) const {
        const int col0 = u.pn * BM + wc * 32 + 8 * fq, row0 = u.pm * BM + wr * 64 + fr;
        EPI_LOOP_ROWS { const size_t off = (size_t)(row0 + ai * HALF + m * 16) * 2048 + col0;
            EPI_LOOP_BJ { *(f32x4*)(out + off + bj * HALF) = acc[ai][bj][m][0]; *(f32x4*)(out + off + bj * HALF + 4) = acc[ai][bj][m][1]; } }
    }
};
struct EpiStoreBf16 { static constexpr bool PERM = true, AFTER_DRAIN = false, MIDK = false;
    bf16_t* out;
    __device__ __forceinline__ void operator()(const f32x4 (&acc)[2][2][4][2], const Unit& u, int wr, int wc, int fr, int fq) const {
        const int col0 = u.pn * BM + wc * 32 + 8 * fq, row0 = u.pm * BM + wr * 64 + fr;
        EPI_LOOP_ROWS { const size_t off = (size_t)(row0 + ai * HALF + m * 16) * 2048 + col0;
            EPI_LOOP_BJ { *(u32x4*)(out + off + bj * HALF) = pack8(acc[ai][bj][m][0], acc[ai][bj][m][1]); } }
    }
};
struct EpiPleGate { static constexpr bool PERM = true, AFTER_DRAIN = false, MIDK = false;
    const bf16_t* pe; const bf16_t* xb; float* out; const float* ss_in; float* ss_out;
    __device__ __forceinline__ void operator()(const f32x4 (&acc)[2][2][4][2], const Unit& u, int wr, int wc, int fr, int fq) const {
        const int col0 = u.pn * BM + wc * 32 + 8 * fq, row0 = u.pm * BM + wr * 64 + fr;
        EPI_LOOP_ROWS { const int row = row0 + ai * HALF + m * 16; const size_t off = (size_t)row * 2048 + col0; float s = 0.f;
            const float rs = __builtin_amdgcn_rsqf(ss_in[row] * (1.f / 2048.f) + 1e-6f);
            EPI_LOOP_BJ { f32x4 g0 = acc[ai][bj][m][0] * rs, g1 = acc[ai][bj][m][1] * rs;
#pragma unroll
                for (int i = 0; i < 4; ++i) { g0[i] = sigm(g0[i]); g1[i] = sigm(g1[i]); }
                const u32x4 xx = *(const u32x4*)(xb + off + bj * HALF), pp = *(const u32x4*)(pe + off + bj * HALF); f32x4 x0, x1, p0, p1; unpack8(xx, x0, x1); unpack8(pp, p0, p1);
                const f32x4 o0 = x0 + p0 * g0, o1 = x1 + p1 * g1;
                *(f32x4*)(out + off + bj * HALF) = o0; *(f32x4*)(out + off + bj * HALF + 4) = o1; s += sq4(o0) + sq4(o1); }
            s += __shfl_xor(s, 16); s += __shfl_xor(s, 32); if (fq == 0) unsafeAtomicAdd(ss_out + row, s); asm volatile("" ::: "memory"); }
    }
};
struct EpiPleGateFinal { static constexpr bool PERM = true, AFTER_DRAIN = true, MIDK = false;
    const bf16_t* pe; const bf16_t* xb; float* out; const float* ss_in; float* ss_out; unsigned* cnt; const float* fg;
    __device__ __forceinline__ void fused(f32x4 (&acc)[2][2][4][2], const Unit& u, int wr, int wc, int fr, int fq, PG8_LAS unsigned char* lds, int wid, int lane) const {
        const int col0 = u.pn * BM + wc * 32 + 8 * fq, row0 = u.pm * BM + wr * 64 + fr;
        float sv[2][4];
        EPI_LOOP_ROWS { const int row = row0 + ai * HALF + m * 16; const size_t off = (size_t)row * 2048 + col0; float s = 0.f;
            const float rs = __builtin_amdgcn_rsqf(ss_in[row] * (1.f / 2048.f) + 1e-6f);
            EPI_LOOP_BJ { f32x4 g0 = acc[ai][bj][m][0] * rs, g1 = acc[ai][bj][m][1] * rs;
#pragma unroll
                for (int i = 0; i < 4; ++i) { g0[i] = sigm(g0[i]); g1[i] = sigm(g1[i]); }
                const u32x4 xx = *(const u32x4*)(xb + off + bj * HALF), pp = *(const u32x4*)(pe + off + bj * HALF); f32x4 x0, x1, p0, p1; unpack8(xx, x0, x1); unpack8(pp, p0, p1);
                const f32x4 o0 = x0 + p0 * g0, o1 = x1 + p1 * g1; acc[ai][bj][m][0] = o0; acc[ai][bj][m][1] = o1; s += sq4(o0) + sq4(o1); }
            s += __shfl_xor(s, 16); s += __shfl_xor(s, 32); sv[ai][m] = s; asm volatile("" ::: "memory"); }
#pragma unroll
        for (int ai = 0; ai < 2; ++ai) { const float t = fq == 0 ? sv[ai][0] : fq == 1 ? sv[ai][1] : fq == 2 ? sv[ai][2] : sv[ai][3]; unsafeAtomicAdd(ss_out + row0 + ai * HALF + fq * 16, t); }
        asm volatile("s_waitcnt vmcnt(0)" ::: "memory");
        __syncthreads();
        if (threadIdx.x == 0) { __hip_atomic_fetch_add(cnt + u.pm, 1u, __ATOMIC_RELAXED, __HIP_MEMORY_SCOPE_AGENT); unsigned sp = 0;
            while (__hip_atomic_load(cnt + u.pm, __ATOMIC_RELAXED, __HIP_MEMORY_SCOPE_AGENT) < 8u) { __builtin_amdgcn_s_sleep(1); if (++sp > (1u << 22)) break; } }
        __syncthreads();
        EPI_LOOP_ROWS { const int row = row0 + ai * HALF + m * 16; const size_t off = (size_t)row * 2048 + col0;
            const float t = __uint_as_float(__hip_atomic_load((unsigned*)(ss_out + row), __ATOMIC_RELAXED, __HIP_MEMORY_SCOPE_AGENT)); const float rs = 1.f / sqrtf(t * (1.f / 2048.f) + 1e-6f);
            EPI_LOOP_BJ { const f32x4 ga = *(const f32x4*)(fg + col0 + bj * HALF), gb = *(const f32x4*)(fg + col0 + bj * HALF + 4);
                *(f32x4*)(out + off + bj * HALF) = acc[ai][bj][m][0] * rs * ga; *(f32x4*)(out + off + bj * HALF + 4) = acc[ai][bj][m][1] * rs * gb; } }
    }
};
struct EpiMerged { static constexpr bool PERM = true, AFTER_DRAIN = false, MIDK = true;
    const bf16_t* GA; const bf16_t* GP; bf16_t* MG;
    __device__ __forceinline__ void mid(f32x4 (&acc)[2][2][4][2], const Unit& u, int wr, int wc, int fr, int fq) const {
        const int col0 = u.pn * BM + wc * 32 + 8 * fq, row0 = u.pm * BM + wr * 64 + fr;
        unsigned long long ro_ = ((unsigned long long)row0 * 2048 + col0) * 2; asm volatile("" : "+v"(ro_));
        const bf16_t* ga = (const bf16_t*)((const char*)GA + ro_); const bf16_t* gp = (const bf16_t*)((const char*)GP + ro_);
#pragma unroll
        for (int ai = 0; ai < 2; ++ai)
#pragma unroll
            for (int m = 0; m < 4; ++m)
#pragma unroll
                for (int bj = 0; bj < 2; ++bj) { const size_t o_ = (size_t)(ai * HALF + m * 16) * 2048 + bj * HALF;
                    const u32x4 a = *(const u32x4*)(ga + o_), p = *(const u32x4*)(gp + o_);
#define RT_(aw, pw, lo) ((lo ? bf_lo(aw) : bf_hi(aw)) * __builtin_amdgcn_rcpf(fmaxf(lo ? bf_lo(pw) : bf_hi(pw), 1e-30f)))
                    acc[ai][bj][m][0][0] *= RT_(a.x, p.x, 1); acc[ai][bj][m][0][1] *= RT_(a.x, p.x, 0); acc[ai][bj][m][0][2] *= RT_(a.y, p.y, 1); acc[ai][bj][m][0][3] *= RT_(a.y, p.y, 0);
                    acc[ai][bj][m][1][0] *= RT_(a.z, p.z, 1); acc[ai][bj][m][1][1] *= RT_(a.z, p.z, 0); acc[ai][bj][m][1][2] *= RT_(a.w, p.w, 1); acc[ai][bj][m][1][3] *= RT_(a.w, p.w, 0);
#undef RT_
                    asm volatile("" ::: "memory"); }
    }
    __device__ __forceinline__ void operator()(const f32x4 (&acc)[2][2][4][2], const Unit& u, int wr, int wc, int fr, int fq) const {
        const int col0 = u.pn * BM + wc * 32 + 8 * fq, row0 = u.pm * BM + wr * 64 + fr;
        EPI_LOOP_ROWS { const size_t off = (size_t)(row0 + ai * HALF + m * 16) * 2048 + col0;
            EPI_LOOP_BJ { const u32x4 g = *(const u32x4*)(GP + off + bj * HALF); f32x4 g0, g1; unpack8(g, g0, g1);
                *(u32x4*)(MG + off + bj * HALF) = pack8(acc[ai][bj][m][0] * g0, acc[ai][bj][m][1] * g1); } asm volatile("" ::: "memory"); }
    }
};
struct EpiDummy { static constexpr bool PERM = true, AFTER_DRAIN = false, MIDK = false;
    bf16_t* O;
    __device__ __forceinline__ void operator()(const f32x4 (&acc)[2][2][4][2], const Unit& u, int wr, int wc, int fr, int fq) const {
        const int col0 = (u.pn & 7) * BM + wc * 32 + 8 * fq, row0 = (u.pm & 7) * BM + wr * 64 + fr;
        EPI_LOOP_ROWS { bf16_t* rowp = O + (size_t)(row0 + ai * HALF + m * 16) * 2048 + col0;
            EPI_LOOP_BJ { *(u32x4*)(rowp + bj * HALF) = pack8(acc[ai][bj][m][0], acc[ai][bj][m][1]); } }
    }
};
struct SubOrder { StaticOrder so; int base, cnt;
    __host__ __device__ bool next(int i, Unit& u) const { return i < cnt ? so.next(base + i, u) : false; }
    __device__ __forceinline__ void a_ready(const Unit&) const {}
    __device__ __forceinline__ void done(const Unit&) const {}
};
struct GroupOrder {
    int G, c;
    __host__ __device__ bool next(int i, Unit& u) const { const int L = i * G + c; if (L >= 32) return false; u.g = L >> 3; u.pm = L & 7; u.pn = 0; return true; }
    __device__ __forceinline__ void a_ready(const Unit&) const {}
    __device__ __forceinline__ void done(const Unit&) const {}
};


template <class Epi, class Sched, bool ALIGN_EPI = false, bool SP2 = false>
__device__ __forceinline__ void gemm_phase(PG8_LAS unsigned char* lds, const Gemm g, const Sched& S, const Epi& E) {
    int tid = threadIdx.x; asm volatile("" : "+v"(tid));   const int wid = __builtin_amdgcn_readfirstlane(tid >> 6), lane = tid & 63, wr = wid >> 2, wc = wid & 3, fr = lane & 15, fq = lane >> 4;
    int K = g.K; asm volatile("" : "+s"(K)); const int nt = K / BK;
    unsigned voffA[2], voffB[2];
#pragma unroll
    for (int i = 0; i < 2; ++i) { int R, C; stage_rc(tid * 16 + i * 8192, R, C); const int Rb = Epi::PERM ? ((R & ~31) + perm32(R & 31)) : R;
        voffA[i] = (unsigned)(R * g.lda + C) * 2u; voffB[i] = (unsigned)(Rb * g.ldb + C) * 2u; }
    const size_t kstep = (size_t)(BK * 2);
    const size_t hstepA = (size_t)HALF * g.lda * 2, hstepB = (size_t)HALF * g.ldb * 2;
    const size_t tstepA = 2 * hstepA, tstepB = 2 * hstepB;
    const unsigned ldsw = (unsigned)wid * 1024u;
    const int aoff = lds_byte(wr * 64 + fr, fq * 8), boff = lds_byte(wc * 32 + fr, fq * 8);
#define PG8_SA(b, h) (((b) * 2 + (h)) * HTB)
#define PG8_SB(b, h) ((4 + (b) * 2 + (h)) * HTB)
#define PG8_STAGE(bufoff, gbase, voff) do { _Pragma("unroll") for (int _i = 0; _i < 2; ++_i) \
        __builtin_amdgcn_global_load_lds((const unsigned*)((const char*)(gbase) + (voff)[_i]), (PG8_LAS unsigned*)(lds + (bufoff) + ldsw + _i * 8192), 16, 0, 0); } while (0)
#define PG8_LDA(dst, b, h) do { _Pragma("unroll") for (int m = 0; m < 4; ++m) _Pragma("unroll") for (int k = 0; k < 2; ++k) dst[m][k] = *(const PG8_LAS bf16x8*)(lds + PG8_SA(b, h) + aoff + m * 2048 + k * 1024); } while (0)
#define PG8_LDB(dst, b, h) do { _Pragma("unroll") for (int n = 0; n < 2; ++n) _Pragma("unroll") for (int k = 0; k < 2; ++k) dst[n][k] = *(const PG8_LAS bf16x8*)(lds + PG8_SB(b, h) + boff + n * 2048 + k * 1024); } while (0)
#define PG8_MMA(ai, bj, At, Bt) do { __builtin_amdgcn_s_setprio(1); _Pragma("unroll") for (int m = 0; m < 4; ++m) _Pragma("unroll") for (int n = 0; n < 2; ++n) _Pragma("unroll") for (int k = 0; k < 2; ++k) \
        acc[ai][bj][m][n] = __builtin_amdgcn_mfma_f32_16x16x32_bf16(Bt[n][k], At[m][k], acc[ai][bj][m][n], 0, 0, 0); __builtin_amdgcn_s_setprio(0); } while (0)
#define PG8_WAIT_V(n) asm volatile("s_waitcnt vmcnt(" #n ")" ::: "memory")
#define PG8_WAIT_L(n) asm volatile("s_waitcnt lgkmcnt(" #n ")" ::: "memory")
#define PG8_BAR __builtin_amdgcn_s_barrier()
#define PG8_SCHED __builtin_amdgcn_sched_barrier(0)
    Unit cur, nxt; int ui = 0;
    if (!S.next(0, cur)) return;
    f32x4 acc[2][2][4][2];
#pragma unroll
    for (int a = 0; a < 2; ++a)
#pragma unroll
        for (int b = 0; b < 2; ++b)
#pragma unroll
            for (int m = 0; m < 4; ++m)
#pragma unroll
                for (int n = 0; n < 2; ++n) acc[a][b][m][n] = (f32x4){0.f, 0.f, 0.f, 0.f};
    bf16x8 At[4][2], B0[2][2], B1[2][2];
    const char* cA = (const char*)(g.A + (size_t)cur.g * g.gsA) + (size_t)cur.pm * tstepA; const char* cB = (const char*)(g.Bt + (size_t)cur.g * g.gsB) + (size_t)cur.pn * tstepB;
    S.a_ready(cur);
    if constexpr (SP2) {
        PG8_STAGE(PG8_SB(0, 0), cB, voffB); PG8_STAGE(PG8_SB(0, 1), cB + hstepB, voffB); PG8_STAGE(PG8_SA(0, 0), cA, voffA); PG8_STAGE(PG8_SA(0, 1), cA + hstepA, voffA);
        if (wr == 1) PG8_BAR;
        PG8_WAIT_V(2); PG8_BAR;
        PG8_STAGE(PG8_SB(1, 0), cB + kstep, voffB); PG8_STAGE(PG8_SA(1, 0), cA + kstep, voffA); PG8_STAGE(PG8_SB(1, 1), cB + hstepB + kstep, voffB);
        PG8_WAIT_V(6); PG8_BAR;
    } else {
        PG8_STAGE(PG8_SB(0, 0), cB, voffB); PG8_STAGE(PG8_SA(0, 0), cA, voffA); PG8_STAGE(PG8_SB(0, 1), cB + hstepB, voffB); PG8_STAGE(PG8_SA(0, 1), cA + hstepA, voffA);
        if (wr == 1) PG8_BAR;
        PG8_WAIT_V(4); PG8_BAR;
        PG8_STAGE(PG8_SB(1, 0), cB + kstep, voffB); PG8_STAGE(PG8_SA(1, 0), cA + kstep, voffA); PG8_STAGE(PG8_SB(1, 1), cB + hstepB + kstep, voffB);
        PG8_WAIT_V(6); PG8_BAR;
    }
    for (;;) {
        const bool has_next = S.next(ui + 1, nxt);
        const char* nA = has_next ? (const char*)(g.A + (size_t)nxt.g * g.gsA) + (size_t)nxt.pm * tstepA : cA; const char* nB = has_next ? (const char*)(g.Bt + (size_t)nxt.g * g.gsB) + (size_t)nxt.pn * tstepB : cB;
        for (int t = 0; t < nt; t += 2) {
            if constexpr (Epi::MIDK) { if (t == (nt >> 1)) { asm volatile("s_waitcnt vmcnt(0)" ::: "memory"); E.mid(acc, cur, wr, wc, fr, fq); asm volatile("s_waitcnt vmcnt(0)" ::: "memory"); } }
            const bool last = (t == nt - 2);
            const char* a1 = cA + (size_t)(t + 1) * kstep;
            const char* a2 = last ? nA : cA + (size_t)(t + 2) * kstep; const char* b2 = last ? nB : cB + (size_t)(t + 2) * kstep;
            const char* a3 = a2 + kstep; const char* b3 = b2 + kstep;
            if (last && has_next) S.a_ready(nxt);
            if constexpr (SP2) {
            PG8_LDB(B0, 0, 0); PG8_LDB(B1, 0, 1); PG8_SCHED; PG8_LDA(At, 0, 0); PG8_STAGE(PG8_SA(1, 1), a1 + hstepA, voffA);
            PG8_WAIT_V(8); PG8_WAIT_L(0); PG8_BAR; PG8_MMA(0, 0, At, B0); PG8_MMA(0, 1, At, B1); PG8_BAR; PG8_SCHED;
            PG8_LDA(At, 0, 1); PG8_STAGE(PG8_SB(0, 0), b2, voffB); PG8_STAGE(PG8_SB(0, 1), b2 + hstepB, voffB); PG8_STAGE(PG8_SA(0, 0), a2, voffA);
            PG8_WAIT_V(8); PG8_WAIT_L(0); PG8_BAR; PG8_MMA(1, 0, At, B0); PG8_MMA(1, 1, At, B1); PG8_BAR; PG8_SCHED;
            PG8_LDB(B0, 1, 0); PG8_LDB(B1, 1, 1); PG8_SCHED; PG8_LDA(At, 1, 0); PG8_STAGE(PG8_SA(0, 1), a2 + hstepA, voffA);
            PG8_WAIT_V(8); PG8_WAIT_L(0); PG8_BAR; PG8_MMA(0, 0, At, B0); PG8_MMA(0, 1, At, B1); PG8_BAR; PG8_SCHED;
            PG8_LDA(At, 1, 1); PG8_STAGE(PG8_SB(1, 0), b3, voffB); PG8_STAGE(PG8_SB(1, 1), b3 + hstepB, voffB); PG8_STAGE(PG8_SA(1, 0), a3, voffA);
            PG8_WAIT_V(8); PG8_WAIT_L(0); PG8_BAR; PG8_MMA(1, 0, At, B0); PG8_MMA(1, 1, At, B1); PG8_BAR; PG8_SCHED;
            } else {
            PG8_LDB(B0, 0, 0); PG8_SCHED; PG8_LDA(At, 0, 0); PG8_STAGE(PG8_SA(1, 1), a1 + hstepA, voffA);
            PG8_WAIT_L(8); PG8_BAR; PG8_WAIT_L(0); PG8_MMA(0, 0, At, B0); PG8_BAR; PG8_SCHED;
            PG8_LDB(B1, 0, 1); PG8_STAGE(PG8_SB(0, 0), b2, voffB);
            PG8_BAR; PG8_WAIT_L(0); PG8_MMA(0, 1, At, B1); PG8_BAR;
            PG8_LDA(At, 0, 1); PG8_STAGE(PG8_SA(0, 0), a2, voffA);
            PG8_BAR; PG8_WAIT_L(0); PG8_MMA(1, 0, At, B0); PG8_BAR; PG8_SCHED;
            PG8_STAGE(PG8_SB(0, 1), b2 + hstepB, voffB);
            PG8_WAIT_V(6); PG8_BAR; PG8_MMA(1, 1, At, B1); PG8_BAR;
            PG8_LDB(B0, 1, 0); PG8_SCHED; PG8_LDA(At, 1, 0); PG8_STAGE(PG8_SA(0, 1), a2 + hstepA, voffA);
            PG8_WAIT_L(8); PG8_BAR; PG8_WAIT_L(0); PG8_MMA(0, 0, At, B0); PG8_BAR; PG8_SCHED;
            PG8_LDB(B1, 1, 1); PG8_STAGE(PG8_SB(1, 0), b3, voffB);
            PG8_BAR; PG8_WAIT_L(0); PG8_MMA(0, 1, At, B1); PG8_BAR;
            PG8_LDA(At, 1, 1); PG8_STAGE(PG8_SA(1, 0), a3, voffA);
            PG8_BAR; PG8_WAIT_L(0); PG8_MMA(1, 0, At, B0); PG8_BAR; PG8_SCHED;
            PG8_STAGE(PG8_SB(1, 1), b3 + hstepB, voffB);
            PG8_WAIT_V(6); PG8_BAR; PG8_MMA(1, 1, At, B1); PG8_BAR;
            }
        }
        if constexpr (ALIGN_EPI) { if (wr == 0) PG8_BAR; }
        if constexpr (!Epi::AFTER_DRAIN) { E(acc, cur, wr, wc, fr, fq); S.done(cur); }
        if (!has_next) break;
#pragma unroll
        for (int a = 0; a < 2; ++a)
#pragma unroll
            for (int b = 0; b < 2; ++b)
#pragma unroll
                for (int m = 0; m < 4; ++m)
#pragma unroll
                    for (int n = 0; n < 2; ++n) acc[a][b][m][n] = (f32x4){0.f, 0.f, 0.f, 0.f};
        cur = nxt; cA = nA; cB = nB; ++ui;
        if constexpr (ALIGN_EPI) { if (wr == 1) PG8_BAR; }
    }
    PG8_WAIT_V(0);
    if constexpr (!ALIGN_EPI) { if (wr == 0) PG8_BAR; }
    PG8_BAR;
    if constexpr (Epi::AFTER_DRAIN) { E.fused(acc, cur, wr, wc, fr, fq, lds, wid, lane); S.done(cur); }
#undef PG8_SA
#undef PG8_SB
#undef PG8_STAGE
#undef PG8_LDA
#undef PG8_LDB
#undef PG8_MMA
#undef PG8_WAIT_V
#undef PG8_WAIT_L
#undef PG8_BAR
#undef PG8_SCHED
}
}
#include <hip/hip_bf16.h>
#include <cmath>
namespace attn_body {
using bf16=__hip_bfloat16;
using bf16x8=__attribute__((ext_vector_type(8)))short;
using s16x4=__attribute__((ext_vector_type(4)))short;
using f32x16=__attribute__((ext_vector_type(16)))float;
using u32x4=__attribute__((ext_vector_type(4)))unsigned;
constexpr int BATCH=1,NHEAD=16,SEQ=8192,D=64,DM=NHEAD*D;
constexpr int NW=8,QBLK=32,QB=QBLK*NW,KVBLK=64,NQB=SEQ/QB;
constexpr int ATTN_PITCH=DM, ATTN_UNIT_ROWS=QB;
__device__ __forceinline__ int crow(int r,int hi){return (r&3)+8*(r>>2)+4*hi;}
#define SBAR() __builtin_amdgcn_sched_barrier(0)
__device__ __forceinline__ void cmask(f32x16&p0,f32x16&p1,int jb,int qrel,int hi){
  const float NEG=-INFINITY; int kb=64*jb+4*hi;
  #pragma unroll
  for(int r=0;r<16;++r){int kv=kb+(r&3)+8*(r>>2); if(kv>qrel)p0[r]=NEG; if(kv+32>qrel)p1[r]=NEG;}
}

constexpr int NSLOT=3, SLOTB=8192;
constexpr int LDS_K=0, LDS_V=NSLOT*SLOTB, LDS_WS=3*NSLOT*SLOTB  , LDS_OST=LDS_WS+NW*64*4, LDS_BYTES=LDS_OST+NW*4096;
constexpr float C2=0.125f*1.4426950408889634f;
__device__ __forceinline__ void glds16(const void*gsrc,unsigned lds_dst){unsigned keep;
  asm volatile("s_mov_b32 %0, m0\n\ts_mov_b32 m0, %2\n\ts_nop 0\n\tglobal_load_lds_dwordx4 %1, off\n\ts_mov_b32 m0, %0":"=&s"(keep):"v"(gsrc),"s"(lds_dst):"memory");}
__device__ __forceinline__ float max3f(float a,float b,float c){float r;asm("v_max3_f32 %0, %1, %2, %3":"=v"(r):"v"(a),"v"(b),"v"(c));return r;}
__device__ __forceinline__ float max2f(float a,float b){float r;asm("v_max_f32_e32 %0, %1, %2":"=v"(r):"v"(a),"v"(b));return r;}
__device__ __forceinline__ float fadd_s(float a,float b){float r;asm("v_add_f32_e32 %0, %1, %2":"=v"(r):"v"(a),"v"(b));return r;}
__device__ __forceinline__ float fsub_s(float a,float b){float r;asm("v_sub_f32_e32 %0, %1, %2":"=v"(r):"v"(a),"v"(b));return r;}
typedef float f32x2_t __attribute__((ext_vector_type(2))); typedef __bf16 bf16x2_t __attribute__((ext_vector_type(2)));
__device__ __forceinline__ unsigned cvtpk_s(float lo,float hi){f32x2_t v={lo,hi};bf16x2_t b=__builtin_convertvector(v,bf16x2_t);return __builtin_bit_cast(unsigned,b);}
#define WAIT_BAR(N) asm volatile("s_waitcnt vmcnt(" #N ") lgkmcnt(0)\n\ts_barrier":::"memory")

__device__ __forceinline__ void qkt(f32x16&p0,f32x16&p1,const char*Kslot,const bf16x8*qr,const f32x16&negm,int r32,int hi){
  const char*kb=Kslot+hi*1024+r32*16;
  #pragma unroll
  for(int d0=0;d0<4;++d0){
    const bf16x8 b0=*reinterpret_cast<const bf16x8*>(kb+d0*2048);
    const bf16x8 b1=*reinterpret_cast<const bf16x8*>(kb+d0*2048+512);
    if(d0==0){p0=__builtin_amdgcn_mfma_f32_32x32x16_bf16(b0,qr[0],negm,0,0,0);p1=__builtin_amdgcn_mfma_f32_32x32x16_bf16(b1,qr[0],negm,0,0,0);}
    else{p0=__builtin_amdgcn_mfma_f32_32x32x16_bf16(b0,qr[d0],p0,0,0,0);p1=__builtin_amdgcn_mfma_f32_32x32x16_bf16(b1,qr[d0],p1,0,0,0);}}
}
typedef __attribute__((address_space(3))) const char* lds_cptr;
typedef short v4i16_t __attribute__((ext_vector_type(4)));
__device__ __forceinline__ void kload8(bf16x8*kf,lds_cptr kp){
  kf[0]=*(const __attribute__((address_space(3))) bf16x8*)(kp);      kf[1]=*(const __attribute__((address_space(3))) bf16x8*)(kp+512);
  kf[2]=*(const __attribute__((address_space(3))) bf16x8*)(kp+2048); kf[3]=*(const __attribute__((address_space(3))) bf16x8*)(kp+2560);
  kf[4]=*(const __attribute__((address_space(3))) bf16x8*)(kp+4096); kf[5]=*(const __attribute__((address_space(3))) bf16x8*)(kp+4608);
  kf[6]=*(const __attribute__((address_space(3))) bf16x8*)(kp+6144); kf[7]=*(const __attribute__((address_space(3))) bf16x8*)(kp+6656);
}
__device__ __forceinline__ void kload2(bf16x8*kf,lds_cptr kp,int j){ kf[2*j]=*(const __attribute__((address_space(3))) bf16x8*)(kp+j*2048); kf[2*j+1]=*(const __attribute__((address_space(3))) bf16x8*)(kp+j*2048+512); }
__device__ __forceinline__ s16x4 vtr(lds_cptr p){ return __builtin_bit_cast(s16x4,__builtin_amdgcn_ds_read_tr16_b64_v4i16((__attribute__((address_space(3))) v4i16_t*)p)); }
__device__ __forceinline__ float rowmax(const f32x16&p0,const f32x16&p1){
  float a=max3f(p0[0],p0[1],p1[0]),b=max3f(p0[2],p0[3],p1[1]);a=max3f(a,p1[2],p1[3]);
  #pragma unroll
  for(int r=4;r<16;r+=4){a=max3f(a,p0[r],p0[r+1]);b=max3f(b,p0[r+2],p0[r+3]);a=max3f(a,p1[r],p1[r+1]);b=max3f(b,p1[r+2],p1[r+3]);}
  const float m=max2f(a,b);
  auto rr=__builtin_amdgcn_permlane32_swap(__float_as_uint(m),__float_as_uint(m),false,false);
  return max2f(__uint_as_float(rr[0]),__uint_as_float(rr[1]));
}
__device__ __forceinline__ void pv(f32x16*o,int vb,bf16x8 pa0,bf16x8 pa1,bf16x8 pa2,bf16x8 pa3){
  #pragma unroll
  for(int d0=0;d0<2;++d0){s16x4 lo[4],hi[4];
    #pragma unroll
    for(int ks=0;ks<4;++ks){
      asm volatile("ds_read_b64_tr_b16 %0,%1 offset:%c2":"=&v"(lo[ks]):"v"(vb),"i"(d0*4096+ks*1024):"memory");
      asm volatile("ds_read_b64_tr_b16 %0,%1 offset:%c2":"=&v"(hi[ks]):"v"(vb),"i"(d0*4096+ks*1024+512):"memory");}
    asm volatile("s_waitcnt lgkmcnt(0)":::"memory");SBAR();
    #define PK(k) (bf16x8){lo[k][0],lo[k][1],lo[k][2],lo[k][3],hi[k][0],hi[k][1],hi[k][2],hi[k][3]}
    o[d0]=__builtin_amdgcn_mfma_f32_32x32x16_bf16(pa0,PK(0),o[d0],0,0,0);
    o[d0]=__builtin_amdgcn_mfma_f32_32x32x16_bf16(pa1,PK(1),o[d0],0,0,0);
    o[d0]=__builtin_amdgcn_mfma_f32_32x32x16_bf16(pa2,PK(2),o[d0],0,0,0);
    o[d0]=__builtin_amdgcn_mfma_f32_32x32x16_bf16(pa3,PK(3),o[d0],0,0,0);
    #undef PK
  }
}

#ifndef ATTN_STORE16
#define ATTN_STORE16(p,v) (*(u32x4*)(p)=(v))
#endif
template<int THRL> __device__ __forceinline__ void attn_unit(int hq,int hv,int qb,const bf16*Q,const bf16*__restrict__ K,const bf16*__restrict__ V,bf16*O,const float slope2,const int t0,const int ntiles,const bool band,float*Lout,const float bref,char*shm){
  int tid=threadIdx.x; asm volatile("":"+v"(tid)); const int lane=tid&63,r32=lane&31,hi=lane>>5; const int wid=__builtin_amdgcn_readfirstlane(tid>>6);
  const long rowbase=0; const int q0=qb*QB;
  const bf16*Qw=Q+(rowbase+q0+wid*QBLK)*DM+hq*D;
  const bf16*Kh=K+(rowbase+(long)t0*KVBLK)*DM+hq*D,*Vh=V+(rowbase+(long)t0*KVBLK)*DM+hv*D;
  const unsigned lds0=(unsigned)(uintptr_t)shm;
  float*wsf=(float*)(shm+LDS_WS)+wid*64;
  const bf16*ksrc=Kh+(long)lane*DM+wid*8;
  const bf16*vsrc=Vh+(long)(16*(wid&3)+(lane>>2))*DM+(wid>>2)*32+(lane&3)*8;
  const unsigned kdst=lds0+LDS_K+wid*1024, vdst=lds0+LDS_V+wid*1024;
  #define DMA_K(t,slot) glds16(ksrc+(long)(t)*KVBLK*DM,(unsigned)__builtin_amdgcn_readfirstlane(kdst+(slot)))
  #define DMA_V(t,slot) do{ glds16(vsrc+(long)(t)*KVBLK*DM,(unsigned)__builtin_amdgcn_readfirstlane(vdst+2*(slot))); glds16(vsrc+64+(long)(t)*KVBLK*DM,(unsigned)__builtin_amdgcn_readfirstlane(vdst+2*(slot)+8192)); }while(0)
  const int vb0=(int)(lds0+LDS_V)+((lane>>4)&1)*32+(lane&3)*8+(4*hi+((lane&15)>>2))*64;
  const char*Kbase=shm+LDS_K; bf16x8 kf[8];
  const lds_cptr shm3=(lds_cptr)shm; const lds_cptr kp0=shm3+LDS_K+hi*1024+r32*16; const lds_cptr vp0=shm3+LDS_V+((lane>>4)&1)*32+(lane&3)*8+(4*hi+((lane&15)>>2))*64;
  const int NT=ntiles;
  DMA_K(0,0);DMA_V(0,0);DMA_K(1,SLOTB);
  bf16x8 qr[4];
  #pragma unroll
  for(int d0=0;d0<4;++d0)qr[d0]=*reinterpret_cast<const bf16x8*>(&Qw[(long)r32*DM+d0*16+hi*8]);
  const int qrel=wid*QBLK+r32;
  const float dstep=64.f*slope2; const float abase=slope2*(float)(64*t0+4*hi-(q0+qrel))-bref;
  float l_reg=0.f;f32x16 o[4];o[0]=f32x16{};o[1]=f32x16{};o[2]=f32x16{};o[3]=f32x16{};const f32x16 negm=f32x16{};
  #define CMASK(P0,P1,t) do{int jb_=(t)-(NT-4); if(band&&jb_>=0)cmask(P0,P1,jb_,qrel,hi);}while(0)
  bool resc=false;
  #define START(P0,P1) do{ resc=false; \
    { const float nm_=abase; \
      _Pragma("unroll") for(int r=0;r<16;++r){ const float kc_=(float)((r&3)+8*(r>>2)); P0[r]=__builtin_fmaf(slope2,kc_,P0[r]+nm_); P1[r]=__builtin_fmaf(slope2,kc_+32.f,P1[r]+nm_); } } \
    _Pragma("unroll") for(int r=0;r<16;++r)P0[r]=__builtin_amdgcn_exp2f(P0[r]); }while(0)
  #define RESC() do{ if(resc){ asm volatile("s_waitcnt lgkmcnt(0)":::"memory"); \
      _Pragma("unroll") for(int d_=0;d_<2;++d_) _Pragma("unroll") for(int r=0;r<16;++r)o[d_][r]*=wsf[crow(r,hi)]; } }while(0)
  f32x16 pA0,pA1,pB0,pB1;
  int sl_prev=0,sl_cur=0,sl_next=SLOTB;
  #define ROT() do{sl_prev=sl_cur;sl_cur=sl_next;sl_next=(sl_next==(NSLOT-1)*SLOTB)?0:sl_next+SLOTB;}while(0)
  DMA_K(2,2*SLOTB);
  WAIT_BAR(4);
  qkt(pA0,pA1,Kbase,qr,negm,r32,hi);asm volatile("s_nop 15\n\ts_nop 7":"+v"(pA0),"+v"(pA1));CMASK(pA0,pA1,0);
  START(pA0,pA1);
  _Pragma("unroll") for(int r=0;r<16;++r)pA1[r]=__builtin_amdgcn_exp2f(pA1[r]);
  WAIT_BAR(0);
  DMA_K(3,0);DMA_V(1,SLOTB);
  ROT();
  kload8(kf,kp0+sl_cur);
  WAIT_BAR(3);
  s16x4 vlo[8],vhi[8]; u32x4 pw0,pw1,pw2,pw3;
  #define PKW(P,B) cvtpk_s(P[B],P[B+1])
  #define PAF(k) __builtin_bit_cast(bf16x8,pw##k)
  #define VFR(i) (bf16x8){vlo[i][0],vlo[i][1],vlo[i][2],vlo[i][3],vhi[i][0],vhi[i][1],vhi[i][2],vhi[i][3]}
  #define PIN(x) asm volatile("":"+v"(x))
  #define MX3(a,b,c) __builtin_fmaxf(__builtin_fmaxf((a),(b)),(c))
  #define GAPA(MF,A0,A1,A2,A3,W0,W1,PW) do{ MF; sacc+=A0; sacc+=A1; sacc+=A2; sacc+=A3; PIN(sacc); W0; W1; PIN(PW); SBAR(); }while(0)
  #define EX(v) __builtin_amdgcn_exp2f(v)
  #define BX(v,k) EX(__builtin_fmaf(slope2,(float)(k),(v)+nm2_))
  #define GAPB(MF,X,B,KO) do{ MF; X[B]=BX(X[B],2*(B)+(KO)); X[B+1]=BX(X[B+1],2*(B)+1+(KO)); X[B+2]=BX(X[B+2],2*(B)+2+(KO)); X[B+3]=BX(X[B+3],2*(B)+3+(KO)); PIN(X); SBAR(); }while(0)
  #define VRD(i) do{ vlo[i]=vtr(vp_+(((i)>>2)*4096+((i)&3)*1024)); vhi[i]=vtr(vp_+(((i)>>2)*4096+((i)&3)*1024+512)); }while(0)
  #define VRD2(i) do{ vlo[i]=vtr(vp_+(8192+((i)>>2)*4096+((i)&3)*1024)); vhi[i]=vtr(vp_+(8192+((i)>>2)*4096+((i)&3)*1024+512)); SBAR(); }while(0)
  #define KRD(G,j) do{ if(G){ kload2(kf,kp0+sl_next,j); SBAR(); } }while(0)
  #define STEP(C0,C1,P0,P1,t,GK,GV,GL) do{ SBAR(); \
    const lds_cptr vp_=vp0+2*sl_prev; \
    VRD(0); SBAR(); float sacc=(P0[0]+P0[1]); \
    GAPA(C0=__builtin_amdgcn_mfma_f32_32x32x16_bf16(kf[0],qr[0],negm,0,0,0), P0[2],P0[3],P0[4],P0[5],     pw0[0]=PKW(P0,0), pw0[1]=PKW(P0,2), pw0); \
    VRD(4); SBAR(); GAPA(C1=__builtin_amdgcn_mfma_f32_32x32x16_bf16(kf[1],qr[0],negm,0,0,0), P0[6],P0[7],P0[8],P0[9],     pw0[2]=PKW(P0,4), pw0[3]=PKW(P0,6), pw0); \
    VRD(1); SBAR(); GAPA(C0=__builtin_amdgcn_mfma_f32_32x32x16_bf16(kf[2],qr[1],C0,0,0,0),   P0[10],P0[11],P0[12],P0[13], pw1[0]=PKW(P0,8), pw1[1]=PKW(P0,10), pw1); \
    VRD(5); SBAR(); GAPA(C1=__builtin_amdgcn_mfma_f32_32x32x16_bf16(kf[3],qr[1],C1,0,0,0),   P0[14],P0[15],P1[0],P1[1],   pw1[2]=PKW(P0,12),pw1[3]=PKW(P0,14), pw1); \
    VRD(2); SBAR(); GAPA(C0=__builtin_amdgcn_mfma_f32_32x32x16_bf16(kf[4],qr[2],C0,0,0,0),   P1[2],P1[3],P1[4],P1[5],     pw2[0]=PKW(P1,0), pw2[1]=PKW(P1,2), pw2); \
    VRD(6); SBAR(); GAPA(C1=__builtin_amdgcn_mfma_f32_32x32x16_bf16(kf[5],qr[2],C1,0,0,0),   P1[6],P1[7],P1[8],P1[9],     pw2[2]=PKW(P1,4), pw2[3]=PKW(P1,6), pw2); \
    VRD(3); SBAR(); GAPA(C0=__builtin_amdgcn_mfma_f32_32x32x16_bf16(kf[6],qr[3],C0,0,0,0),   P1[10],P1[11],P1[12],P1[13], pw3[0]=PKW(P1,8), pw3[1]=PKW(P1,10), pw3); \
    VRD(7); SBAR(); GAPA(C1=__builtin_amdgcn_mfma_f32_32x32x16_bf16(kf[7],qr[3],C1,0,0,0),   P1[14],P1[15],0.f,0.f,       pw3[2]=PKW(P1,12),pw3[3]=PKW(P1,14), pw3); \
    l_reg+=sacc; \
    if(GK){DMA_K((t)+3,sl_cur);} if(GV){DMA_V((t)+1,sl_next);} \
    CMASK(C0,C1,t); \
    const float nm2_=__builtin_fmaf(dstep,(float)(t),abase); \
    SBAR(); \
    GAPB(o[0]=__builtin_amdgcn_mfma_f32_32x32x16_bf16(PAF(0),VFR(0),o[0],0,0,0), C0,0,0); VRD2(0); \
    GAPB(o[1]=__builtin_amdgcn_mfma_f32_32x32x16_bf16(PAF(0),VFR(4),o[1],0,0,0), C0,4,0); VRD2(4); \
    KRD(GL,0); GAPB(o[0]=__builtin_amdgcn_mfma_f32_32x32x16_bf16(PAF(1),VFR(1),o[0],0,0,0), C0,8,0); VRD2(1); \
    KRD(GL,1); GAPB(o[1]=__builtin_amdgcn_mfma_f32_32x32x16_bf16(PAF(1),VFR(5),o[1],0,0,0), C0,12,0); VRD2(5); \
    KRD(GL,2); GAPB(o[0]=__builtin_amdgcn_mfma_f32_32x32x16_bf16(PAF(2),VFR(2),o[0],0,0,0), C1,0,32); VRD2(2); \
    KRD(GL,3); GAPB(o[1]=__builtin_amdgcn_mfma_f32_32x32x16_bf16(PAF(2),VFR(6),o[1],0,0,0), C1,4,32); VRD2(6); \
    GAPB(o[0]=__builtin_amdgcn_mfma_f32_32x32x16_bf16(PAF(3),VFR(3),o[0],0,0,0), C1,8,32); VRD2(3); \
    GAPB(o[1]=__builtin_amdgcn_mfma_f32_32x32x16_bf16(PAF(3),VFR(7),o[1],0,0,0), C1,12,32); VRD2(7); \
    SBAR(); \
    o[2]=__builtin_amdgcn_mfma_f32_32x32x16_bf16(PAF(0),VFR(0),o[2],0,0,0); \
    o[3]=__builtin_amdgcn_mfma_f32_32x32x16_bf16(PAF(0),VFR(4),o[3],0,0,0); \
    o[2]=__builtin_amdgcn_mfma_f32_32x32x16_bf16(PAF(1),VFR(1),o[2],0,0,0); \
    o[3]=__builtin_amdgcn_mfma_f32_32x32x16_bf16(PAF(1),VFR(5),o[3],0,0,0); \
    o[2]=__builtin_amdgcn_mfma_f32_32x32x16_bf16(PAF(2),VFR(2),o[2],0,0,0); \
    o[3]=__builtin_amdgcn_mfma_f32_32x32x16_bf16(PAF(2),VFR(6),o[3],0,0,0); \
    o[2]=__builtin_amdgcn_mfma_f32_32x32x16_bf16(PAF(3),VFR(3),o[2],0,0,0); \
    o[3]=__builtin_amdgcn_mfma_f32_32x32x16_bf16(PAF(3),VFR(7),o[3],0,0,0); \
    SBAR(); \
    }while(0)
  int t=1;
  #undef CMASK
  #define CMASK(P0,P1,t) do{}while(0)
  for(;t+5<NT;t+=2){
    STEP(pB0,pB1,pA0,pA1,t,true,true,true);     WAIT_BAR(3); RESC(); ROT();
    STEP(pA0,pA1,pB0,pB1,t+1,true,true,true);   WAIT_BAR(3); RESC(); ROT();
  }
  #undef CMASK
  #define CMASK(P0,P1,t) do{int jb_=(t)-(NT-4); if(band&&jb_>=0)cmask(P0,P1,jb_,qrel,hi);}while(0)
  #define ENDW(tt) do{ if((tt)+3<NT){WAIT_BAR(3);} else if((tt)+2<NT){WAIT_BAR(2);} else {WAIT_BAR(0);} }while(0)
  for(;t+1<NT;t+=2){
    STEP(pB0,pB1,pA0,pA1,t,(t+3<NT),(t+1<NT),(t+1<NT));       ENDW(t);   RESC(); ROT();
    STEP(pA0,pA1,pB0,pB1,t+1,(t+4<NT),(t+2<NT),(t+2<NT));     ENDW(t+1); RESC(); ROT();
  }
  STEP(pB0,pB1,pA0,pA1,NT-1,false,false,false); RESC();
  { float sacc=pB0[0]+pB0[1]; _Pragma("unroll") for(int r=2;r<16;++r)sacc+=pB0[r]; _Pragma("unroll") for(int r=0;r<16;++r)sacc+=pB1[r]; l_reg+=sacc;
    pw0=(u32x4){PKW(pB0,0),PKW(pB0,2),PKW(pB0,4),PKW(pB0,6)};pw1=(u32x4){PKW(pB0,8),PKW(pB0,10),PKW(pB0,12),PKW(pB0,14)};pw2=(u32x4){PKW(pB1,0),PKW(pB1,2),PKW(pB1,4),PKW(pB1,6)};pw3=(u32x4){PKW(pB1,8),PKW(pB1,10),PKW(pB1,12),PKW(pB1,14)};
    SBAR(); pv(o,vb0+2*sl_cur,PAF(0),PAF(1),PAF(2),PAF(3)); pv(o+2,vb0+2*sl_cur+8192,PAF(0),PAF(1),PAF(2),PAF(3)); }
  #undef PKW
  #undef PAF
  #undef VFR
  #undef PIN
  #undef MX3
  #undef GAPA
  #undef GAPB
  #undef BX
  #undef EX
  #undef VRD
  #undef VRD2
  #undef KRD
  #undef STEP
  #undef ENDW
  {auto rr=__builtin_amdgcn_permlane32_swap(__float_as_uint(l_reg),__float_as_uint(l_reg),false,false);l_reg=__uint_as_float(rr[0])+__uint_as_float(rr[1]);}
  if(hi==0){wsf[32+r32]=l_reg; if(Lout)Lout[(long)(q0+qrel)*8]=l_reg;}asm volatile("s_waitcnt lgkmcnt(0)":::"memory");
  float rli[16];
  #pragma unroll
  for(int r=0;r<16;++r)rli[r]=__builtin_amdgcn_rcpf(wsf[32+crow(r,hi)]);
  bf16*Ow=O+(rowbase+q0+wid*QBLK)*DM+hv*D;
  { bf16*stg=(bf16*)(shm+LDS_OST)+wid*2048;
    #pragma unroll
    for(int hf=0;hf<2;++hf){
      #pragma unroll
      for(int r=0;r<16;++r){const int orow=crow(r,hi);
        #pragma unroll
        for(int d0=0;d0<2;++d0)stg[orow*64+d0*32+r32]=__float2bfloat16(o[2*hf+d0][r]*rli[r]);}
      asm volatile("s_waitcnt lgkmcnt(0)":::"memory");
      #pragma unroll
      for(int i=0;i<4;++i){const int row=i*8+(lane>>3),ch=lane&7; const u32x4 v=*(const u32x4*)(stg+row*64+ch*8); ATTN_STORE16(Ow+(long)row*DM+hf*64+ch*8,v);}
      asm volatile("s_waitcnt lgkmcnt(0)":::"memory"); } }
  asm volatile("s_waitcnt lgkmcnt(0)\n\ts_barrier":::"memory");
  #undef DMA_K
  #undef DMA_V
  #undef CMASK
  #undef START
  #undef RESC
  #undef ROT
}
constexpr int ATTN_LDS_BYTES=LDS_BYTES;
struct AttnTensors { const bf16* Q; const bf16* K; const bf16* V; bf16* O; bf16* O2; };
struct AttnUnit { int bh; int qb; };
struct StaticOrder {
  int vcu;
  __device__ __forceinline__ explicit StaticOrder(int grid,int block):vcu((block%8)*(grid/8)+block/8){}
  __device__ __forceinline__ bool next(int i,AttnUnit&u)const{ if(i>=4)return false; const int s=vcu&7; u.bh=vcu>>3; u.qb=(i==0)?s:(i==1)?15-s:(i==2)?16+s:31-s; return true; }
  __device__ __forceinline__ void a_ready(const AttnUnit&)const{}
  __device__ __forceinline__ void done(const AttnUnit&)const{}
};
template<class Sched,int THRL=8> __device__ __forceinline__ void attn_phase(char*lds,const AttnTensors&T,const Sched&S){
  AttnUnit u;
  for(int i=0;S.next(i,u);++i){ S.a_ready(u); { const int h_=u.bh>>2, c_=(u.bh>>1)&1, vh_=u.bh&1; attn_unit<THRL>(c_*8+h_, 2*h_+vh_, u.qb, T.Q, T.K, T.V, c_? T.O2 : T.O, __builtin_exp2f(-(float)(h_+1))*1.4426950408889634f, 0, 4*u.qb+4, true, nullptr, 64.f, lds); } S.done(u); }
}
#undef SBAR
#undef WAIT_BAR
}
#ifndef REP_P0
#define REP_P0 1
#endif
#ifndef REP_P1
#define REP_P1 1
#endif
#ifndef REP_P2
#define REP_P2 1
#endif
#ifndef REP_P3
#define REP_P3 1
#endif
#ifndef REP_G4
#define REP_G4 0
#endif
#ifndef REP_G6
#define REP_G6 0
#endif
#ifndef REP_P4
#define REP_P4 1
#endif
#ifndef REP_P5
#define REP_P5 1
#endif
constexpr int NWAVES = 8;
constexpr int S = 8192, DM = 2048, INW = 8192, FF = 8192, PLE = 256, ATTW = 1024;
constexpr float NORM_EPS = 1e-6f;
constexpr float LAM_INIT = 0.2f;
constexpr float QSCALE = 0.125f * 1.4426950408889634f;
constexpr size_t MiB = 1u << 20;
constexpr size_t WS_BAR = 1u << 20;
constexpr size_t WS_FLAGS = (1u << 20) + 65536;
constexpr size_t WS_SS = 0;
constexpr size_t WS_WIN = 2 * MiB, WS_WUP = 34 * MiB, WS_WDN = 66 * MiB, WS_WOUT = 98 * MiB, WS_WPG = 106 * MiB, WS_WPB = 114 * MiB, WS_WBR = 118 * MiB  , WS_WPLE = 126 * MiB, WS_PGW = 127 * MiB;
constexpr size_t WS_PB = 128 * MiB;
constexpr size_t WS_HN = 132 * MiB;
constexpr size_t WS_Z = 164 * MiB;
constexpr size_t WS_G = 228 * MiB;
constexpr size_t WS_AB2 = 132 * MiB;
constexpr size_t WS_SCR = 292 * MiB;
constexpr size_t WS_MG = 164 * MiB;
constexpr size_t WS_XB = 260 * MiB;
constexpr size_t WS_H = 132 * MiB;
constexpr size_t WS_PE = 132 * MiB;
constexpr size_t WS_END = 308 * MiB;
constexpr int LDS_BYTES = 131072 + 1024;
constexpr int ATT_SPLIT_MIN = 16;

#define GAS __attribute__((address_space(1)))
#define LAS __attribute__((address_space(3)))
typedef unsigned short bfu;
typedef unsigned v4u __attribute__((ext_vector_type(4)));
typedef float f32x4 __attribute__((ext_vector_type(4)));
#define LDS_WAIT() asm volatile("s_waitcnt lgkmcnt(0)" ::: "memory")
__device__ __forceinline__ unsigned f2bf(float f) { unsigned u = __builtin_bit_cast(unsigned, f); return (u + 0x7fffu + ((u >> 16) & 1u)) >> 16; }
__device__ __forceinline__ unsigned pk2(float lo, float hi) { return f2bf(lo) | (f2bf(hi) << 16); }
__device__ __forceinline__ float wave_sum(float v) {
#pragma unroll
    for (int o = 1; o < 64; o <<= 1) v += __shfl_xor(v, o);
    return v;
}
__device__ __forceinline__ void p0_transpose_item(const float* W, int K, int N, bfu* WT, const float* gain, LAS float*  , int item, int lane, int ldk = 0) {
    if (ldk == 0) ldk = K;
    const int nblk = N / 32, kb = item / nblk, nb = item % nblk, k0 = 64 * kb, n0 = 32 * nb, kg = lane >> 3, n4 = lane & 7;
    const float* src = W + (size_t)(k0 + 8 * kg) * N + n0 + 4 * n4;
    f32x4 v[8];
#pragma unroll
    for (int j = 0; j < 8; ++j) v[j] = __builtin_nontemporal_load((const f32x4*)(src + (size_t)j * N));
    if (gain) { const f32x4 g0 = *(const f32x4*)(gain + k0 + 8 * kg), g1 = *(const f32x4*)(gain + k0 + 8 * kg + 4);
#pragma unroll
        for (int j = 0; j < 4; ++j) { v[j] = v[j] * g0[j]; v[4 + j] = v[4 + j] * g1[j]; } }
    bfu* dst = WT + (size_t)(n0 + 4 * n4) * ldk + k0 + 8 * kg;
#pragma unroll
    for (int i = 0; i < 4; ++i) { v4u o; o.x = pk2(v[0][i], v[1][i]); o.y = pk2(v[2][i], v[3][i]); o.z = pk2(v[4][i], v[5][i]); o.w = pk2(v[6][i], v[7][i]); *(v4u*)(dst + (size_t)i * ldk) = o; }
}
#define XB_TMO      128
#define XB_XCNT(j)  (256  + 64 * (j))
#define XB_XSUB(j)  (1280 + 64 * (j))
#define XB_XGEN(j)  (2304 + 64 * (j))
#define XB_TOP      3328
#define XB_TOPGEN   3392
#define XCD_BAR_WORDS 3456
#define XB_SPIN_CAP (1u << 18)

__device__ __forceinline__ unsigned xb_ld(unsigned* p)              { return __hip_atomic_load(p, __ATOMIC_RELAXED, __HIP_MEMORY_SCOPE_AGENT); }
__device__ __forceinline__ unsigned xb_add(unsigned* p, unsigned v) { return __hip_atomic_fetch_add(p, v, __ATOMIC_RELAXED, __HIP_MEMORY_SCOPE_AGENT); }
__device__ __forceinline__ unsigned xb_xcc_id() { return (unsigned)__builtin_amdgcn_s_getreg((3 << 11) | 20) & 0xFu; }
#define XB_SPIN(cond, bar) do { unsigned _sp = 0; while (cond) { __builtin_amdgcn_s_sleep(1); \
    if ((++_sp & 255u) == 0u) { if (xb_ld(&(bar)[XB_TMO])) break; if (_sp > XB_SPIN_CAP) { atomicAdd(&(bar)[XB_TMO], 1u); break; } } } } while (0)

struct XcdBarrier {
    unsigned* bar; unsigned x;
    volatile LAS unsigned* st;
};

__device__ __forceinline__ XcdBarrier xcd_barrier_post(unsigned* bar, volatile LAS unsigned* st) {
    XcdBarrier b; b.bar = bar; b.x = xb_xcc_id(); b.st = st;
    if (threadIdx.x == 0) (void)xb_add(&bar[XB_XCNT(b.x)], 1u);
    return b;
}
__device__ __forceinline__ void xcd_barrier_complete(unsigned* bar, unsigned x, unsigned& nloc, unsigned& nx) {
    const unsigned G = gridDim.x * gridDim.y * gridDim.z;
    unsigned sum, cnt, mine, sp = 0u;
    for (;;) {
        sum = 0u; cnt = 0u; mine = 0u;
#pragma unroll
        for (unsigned j = 0; j < 16; ++j) { const unsigned c = xb_ld(&bar[XB_XCNT(j)]); sum += c; cnt += (c > 0u) ? 1u : 0u; mine = (j == x) ? c : mine; }
        if (sum == G) break;
        __builtin_amdgcn_s_sleep(1);
        if ((++sp & 255u) == 0u) { if (xb_ld(&bar[XB_TMO])) break; if (sp > XB_SPIN_CAP) { atomicAdd(&bar[XB_TMO], 1u); break; } }
    }
    nloc = mine > 0u ? mine : 1u; nx = cnt > 0u ? cnt : 1u;
}

__device__ __forceinline__ void xcd_barrier(const XcdBarrier& b) {
    asm volatile("s_waitcnt vmcnt(0)" ::: "memory");
    __syncthreads();
    if (threadIdx.x == 0) {
        unsigned* bar = b.bar;
        __builtin_amdgcn_s_waitcnt(0);
        unsigned nloc = b.st[0], nx = b.st[1];
        if (nloc == 0u) { xcd_barrier_complete(bar, b.x, nloc, nx); b.st[0] = nloc; b.st[1] = nx; }
        const unsigned old = xb_add(&bar[XB_XSUB(b.x)], 1u);
        const unsigned gen = old / nloc;
        if (old + 1u == (gen + 1u) * nloc) {
            __builtin_amdgcn_fence(__ATOMIC_RELEASE, "agent");
            asm volatile("s_waitcnt vmcnt(0)" ::: "memory");
            const unsigned og = xb_add(&bar[XB_TOP], 1u);
            const unsigned tg = og / nx;
            if (og + 1u == (tg + 1u) * nx) xb_add(&bar[XB_TOPGEN], 1u);
            else XB_SPIN(xb_ld(&bar[XB_TOPGEN]) == tg, bar);
            __builtin_amdgcn_fence(__ATOMIC_ACQUIRE, "agent");
            xb_add(&bar[XB_XGEN(b.x)], 1u);
            asm volatile("s_waitcnt vmcnt(0)" ::: "memory");
        } else {
            XB_SPIN(xb_ld(&bar[XB_XGEN(b.x)]) == gen, bar);
            __builtin_amdgcn_fence(__ATOMIC_ACQUIRE, "agent");
            asm volatile("s_waitcnt vmcnt(0)" ::: "memory");
        }
    }
    __syncthreads();
}

constexpr unsigned long long FLAG_TOKEN = 0x5EA70B0A7C0FFEE1ull, FLAG_CLOSED = 0xC105EDC105EDC105ull;
__device__ __forceinline__ void flag_barrier(unsigned long long* slots, unsigned G, unsigned me) {
    asm volatile("s_waitcnt vmcnt(0)" ::: "memory");
    __syncthreads();
    if (threadIdx.x < 64) {
        if (threadIdx.x == 0) { __builtin_amdgcn_fence(__ATOMIC_RELEASE, "agent"); asm volatile("s_waitcnt vmcnt(0)" ::: "memory");
            __hip_atomic_store(slots + me, FLAG_TOKEN, __ATOMIC_RELAXED, __HIP_MEMORY_SCOPE_AGENT); }
        unsigned sp = 0;
        for (;;) { bool ok = true;
            for (unsigned i = threadIdx.x; i < G; i += 64) ok = ok && (__hip_atomic_load(slots + i, __ATOMIC_RELAXED, __HIP_MEMORY_SCOPE_AGENT) == FLAG_TOKEN);
            if (__all(ok)) break;
            __builtin_amdgcn_s_sleep(2); if (++sp > (1u << 20)) break; }
        __builtin_amdgcn_fence(__ATOMIC_ACQUIRE, "agent"); asm volatile("s_waitcnt vmcnt(0)" ::: "memory");
    }
    __syncthreads();
}
template <int W> __device__ __forceinline__ void pool_item(const bfu* u, bfu* pooled, int tb) {
    v4u r[W + 7];
#pragma unroll
    for (int j = 0; j < W + 7; ++j) { const int t = tb - (W - 1) + j; r[j] = (t >= 0) ? *(const v4u*)(u + (size_t)t * 1024) : (v4u){0u, 0u, 0u, 0u}; }
    float a[8];
#pragma unroll
    for (int e = 0; e < 8; ++e) a[e] = 0.f;
#pragma unroll
    for (int j = 0; j < W - 1; ++j) { a[0] += pg8::bf_lo(r[j].x); a[1] += pg8::bf_hi(r[j].x); a[2] += pg8::bf_lo(r[j].y); a[3] += pg8::bf_hi(r[j].y); a[4] += pg8::bf_lo(r[j].z); a[5] += pg8::bf_hi(r[j].z); a[6] += pg8::bf_lo(r[j].w); a[7] += pg8::bf_hi(r[j].w); }
#pragma unroll
    for (int k = 0; k < 8; ++k) {
        const v4u c = r[W - 1 + k]; const int t = tb + k;
        const float cv[8] = {pg8::bf_lo(c.x), pg8::bf_hi(c.x), pg8::bf_lo(c.y), pg8::bf_hi(c.y), pg8::bf_lo(c.z), pg8::bf_hi(c.z), pg8::bf_lo(c.w), pg8::bf_hi(c.w)};
#pragma unroll
        for (int e = 0; e < 8; ++e) a[e] += cv[e];
        const float inv = 1.f / (float)((t + 1) < W ? (t + 1) : W);
        v4u o; o.x = pk2(a[0] * inv - cv[0], a[1] * inv - cv[1]); o.y = pk2(a[2] * inv - cv[2], a[3] * inv - cv[3]); o.z = pk2(a[4] * inv - cv[4], a[5] * inv - cv[5]); o.w = pk2(a[6] * inv - cv[6], a[7] * inv - cv[7]);
        *(v4u*)(pooled + (size_t)t * 2048) = o;
        const v4u d = r[k];
        a[0] -= pg8::bf_lo(d.x); a[1] -= pg8::bf_hi(d.x); a[2] -= pg8::bf_lo(d.y); a[3] -= pg8::bf_hi(d.y); a[4] -= pg8::bf_lo(d.z); a[5] -= pg8::bf_hi(d.z); a[6] -= pg8::bf_lo(d.w); a[7] -= pg8::bf_hi(d.w);
    }
}
__device__ __forceinline__ void* ldp(LAS unsigned long long* tbl, int i) { const unsigned long long v = tbl[i];
    const unsigned lo = __builtin_amdgcn_readfirstlane((unsigned)v), hi = __builtin_amdgcn_readfirstlane((unsigned)(v >> 32)); return (void*)(((unsigned long long)hi << 32) | lo); }
struct Args { const float* in[21]; float* out; unsigned char* ws; int use_cg_sync; int pad; };

__global__ void __launch_bounds__(NWAVES * 64, 2) fwd_megakernel(Args args) {
    extern __shared__ __attribute__((aligned(16))) unsigned char lds[];
    LAS unsigned char* ldsp = (LAS unsigned char*)lds;
    const int G = gridDim.x, bx = blockIdx.x;
    const int vcu = (G % 8 == 0) ? (bx % 8) * (G / 8) + bx / 8 : bx;
    const int NGW = G * NWAVES, NGT = G * NWAVES * 64;
#define PHASE_IDS int tid = threadIdx.x; asm volatile("" : "+v"(tid)); const int lane = tid & 63, wave = __builtin_amdgcn_readfirstlane(tid >> 6); const int gw = vcu * NWAVES + wave, gt = bx * (NWAVES * 64) + tid; (void)lane; (void)gw; (void)gt
    LAS unsigned long long* ptab = (LAS unsigned long long*)(ldsp + 131072);
    if (threadIdx.x < 2) ((LAS unsigned*)(ldsp + 131072 + 768))[threadIdx.x] = 0u;
    if (threadIdx.x == 0) {
        ptab[0] = (unsigned long long)args.in[0]; ptab[1] = (unsigned long long)args.in[1]; ptab[2] = (unsigned long long)args.in[2]; ptab[3] = (unsigned long long)args.in[3];
        ptab[4] = (unsigned long long)args.in[4]; ptab[5] = (unsigned long long)args.in[5]; ptab[6] = (unsigned long long)args.in[6]; ptab[7] = (unsigned long long)args.in[7];
        ptab[8] = (unsigned long long)args.in[8]; ptab[9] = (unsigned long long)args.in[9]; ptab[10] = (unsigned long long)args.in[10]; ptab[11] = (unsigned long long)args.in[11];
        ptab[12] = (unsigned long long)args.in[12]; ptab[13] = (unsigned long long)args.in[13]; ptab[14] = (unsigned long long)args.in[14]; ptab[15] = (unsigned long long)args.in[15];
        ptab[16] = (unsigned long long)args.in[16]; ptab[17] = (unsigned long long)args.in[17]; ptab[18] = (unsigned long long)args.in[18]; ptab[19] = (unsigned long long)args.in[19];
        ptab[20] = (unsigned long long)args.in[20]; ptab[21] = (unsigned long long)args.out; ptab[22] = (unsigned long long)args.ws;
    }
    __syncthreads();
    if (args.use_cg_sync) cg::this_grid().sync();
#define GRID_BAR() do { XcdBarrier b_; b_.bar = (unsigned*)(WSB + WS_BAR); b_.x = xb_xcc_id(); b_.st = (volatile LAS unsigned*)(ldsp + 131072 + 768); xcd_barrier(b_); } while (0)
#define INP(i) ((const float*)ldp(ptab, (i)))
#define OUTP ((float*)ldp(ptab, 21))
#define WSB ((unsigned char*)ldp(ptab, 22))
#define WSP(T, off) ((T*)(ws + (off)))
#define DEF_WS unsigned char* ws = WSB
    {
        PHASE_IDS; DEF_WS; LAS float* scr = (LAS float*)(ldsp + wave * 16384); const float* x = INP(0); const float* p = INP(1); const float* norm_mix_g = INP(2); const float* w_in = INP(3); const float* pool_grp_w = INP(9); const float* pool_scale = INP(10);
        const float* w_attn_br = INP(11); const float* w_pool_br = INP(12); const float* w_out = INP(13); const float* norm_mlp_g = INP(14); const float* w_up = INP(15); const float* w_dn = INP(16);
        const float* norm_ple_g = INP(17); const float* w_ple = INP(18); const float* w_pg = INP(19);
        float* ss1 = WSP(float, WS_SS); bfu* WIN = WSP(bfu, WS_WIN); bfu* WUP = WSP(bfu, WS_WUP); bfu* WDN = WSP(bfu, WS_WDN); bfu* WOUT = WSP(bfu, WS_WOUT); bfu* WPG = WSP(bfu, WS_WPG);
        bfu* WBR = WSP(bfu, WS_WBR); bfu* WPB = WSP(bfu, WS_WPB); bfu* WPLE = WSP(bfu, WS_WPLE); bfu* PGW = WSP(bfu, WS_PGW); bfu* PB = WSP(bfu, WS_PB); bfu* HN = WSP(bfu, WS_HN);
        for (int rep_ = 0; rep_ < REP_P0; ++rep_) {
        constexpr int I_IN = (DM / 64) * (INW / 32), I_AB = (ATTW / 64) * (DM / 32), I_PB = I_AB;
        constexpr int NITEMS = I_IN + I_AB + I_PB;
        for (int it = gw; it < NITEMS; it += NGW) {
            int r = it;
            if (r < I_IN) { p0_transpose_item(w_in, DM, INW, WIN, nullptr, scr, r, lane); continue; } r -= I_IN;
            if (r < I_AB) { p0_transpose_item(w_attn_br, ATTW, DM, WBR, nullptr, scr, r, lane, 2048); continue; } r -= I_AB;
            p0_transpose_item(w_pool_br, ATTW, DM, WPB, pool_scale, scr, r, lane);
        }
        for (int i = gt; i < (4 * 256 * 256) / 4; i += NGT) { const f32x4 v = ((const f32x4*)pool_grp_w)[i]; ((uint2*)PGW)[i] = make_uint2(pk2(v[0], v[1]), pk2(v[2], v[3])); }
        for (int i = gt; i < 3 * S + 128; i += NGT) ss1[i] = 0.f;
        for (int i = gt; i < 4096; i += NGT) WSP(unsigned, WS_BAR)[i] = 0u;
        for (int m = gw; m < S; m += NGW) {
            const f32x4* xr = (const f32x4*)(x + (size_t)m * DM) + lane; f32x4 v[8]; float s = 0.f;
#pragma unroll
            for (int j = 0; j < 8; ++j) { v[j] = __builtin_nontemporal_load(xr + 64 * j); s += pg8::sq4(v[j]); }
            const float rs = 1.f / sqrtf(wave_sum(s) * (1.f / DM) + NORM_EPS);
            uint2* o8 = (uint2*)(HN + (size_t)m * DM) + lane;
#pragma unroll
            for (int j = 0; j < 8; ++j) { const f32x4 g = ((const f32x4*)norm_mix_g)[64 * j + lane]; o8[64 * j] = make_uint2(pk2(v[j][0] * rs * g[0], v[j][1] * rs * g[1]), pk2(v[j][2] * rs * g[2], v[j][3] * rs * g[3])); }
        }
        }
    }
    flag_barrier((unsigned long long*)(WSB + WS_FLAGS), gridDim.x, blockIdx.x);
    if (threadIdx.x == 0) (void)xb_add(&((unsigned*)(WSB + WS_BAR))[XB_XCNT(xb_xcc_id())], 1u);

    {
        PHASE_IDS; DEF_WS; bfu* HN = WSP(bfu, WS_HN); bfu* WIN = WSP(bfu, WS_WIN); bfu* Z = WSP(bfu, WS_Z); bfu* GT = WSP(bfu, WS_G); bfu* WPB = WSP(bfu, WS_WPB); bfu* PGW = WSP(bfu, WS_PGW); bfu* WBR = WSP(bfu, WS_WBR);
        pg8::Gemm g{HN, WIN, S, INW, DM, DM, DM, 0, 0}; pg8::StaticOrder so; so.init(S, INW, G, bx);
        pg8::EpiInProj E{Z, GT, QSCALE, (unsigned*)(WSP(float, WS_SS) + 3 * S)};
        for (int rep_ = 0; rep_ < REP_P1; ++rep_) pg8::gemm_phase<pg8::EpiInProj, pg8::StaticOrder, true, true>(ldsp, g, so, E);
    }
    GRID_BAR();

    {
        PHASE_IDS; DEF_WS; bfu* Z = WSP(bfu, WS_Z); bfu* Qb = Z; bfu* Kb = Z + (size_t)S * 1024; bfu* Vb = Z + (size_t)2 * S * 1024; bfu* Ub = Z + (size_t)3 * S * 1024;
        bfu* AB2 = WSP(bfu, WS_AB2); bfu* Obase = (bfu*)OUTP; float* Lbase = WSP(float, WS_SCR);
        { bfu* WPB = WSP(bfu, WS_WPB); bfu* PGW = WSP(bfu, WS_PGW); bfu* WBR = WSP(bfu, WS_WBR);
        pg8::Gemm g2{WPB, PGW, DM, 256, 256, 1024, 256, 256, 65536}; pg8::GroupOrder go{G, bx};
        pg8::EpiBf16G E2{WBR + 1024, 2048, 256};
        pg8::gemm_phase<pg8::EpiBf16G, pg8::GroupOrder, true, true>(ldsp, g2, go, E2);
        }
        __syncthreads();
        unsigned* nmax = (unsigned*)(WSP(float, WS_SS) + 3 * S); unsigned* qctr = nmax + 64;
        LAS unsigned* qw = (LAS unsigned*)(ldsp + 131072 + 512);
        for (int rep_ = 0; rep_ < REP_P2; ++rep_) { bool first_ = true;
        for (;;) {
            if (threadIdx.x == 0) *qw = first_ ? (unsigned)bx : (unsigned)G + __hip_atomic_fetch_add(qctr + rep_, 1u, __ATOMIC_RELAXED, __HIP_MEMORY_SCOPE_AGENT);
            first_ = false;
            __syncthreads();
            const unsigned pidx = __builtin_amdgcn_readfirstlane(*qw);
            if (pidx >= 1152u) break;
            if (pidx < 512u && (pidx & 1u) == 1u) {
                const int ci = (int)(pidx >> 1);
                constexpr int J_UP = (DM / 64) * (FF / 32), J_DN = (FF / 64) * (DM / 32), J_OUT = (DM / 64) * (DM / 32), J_PG = J_OUT, J_PLE = (PLE / 64) * (DM / 32), J_ALL = J_UP + J_DN + J_OUT + J_PG + J_PLE;
                static_assert(J_ALL == 256 * 81, "conversion items");
#pragma unroll 1
                for (int k2 = 0; k2 < 11; ++k2) { const int wi = wave + 8 * k2; if (wi >= 81) break; int r = ci * 81 + wi;
                    if (r < J_UP) { p0_transpose_item(INP(15), DM, FF, WSP(bfu, WS_WUP), INP(14), nullptr, r, lane); continue; } r -= J_UP;
                    if (r < J_DN) { p0_transpose_item(INP(16), FF, DM, WSP(bfu, WS_WDN), nullptr, nullptr, r, lane); continue; } r -= J_DN;
                    if (r < J_OUT) { p0_transpose_item(INP(13), DM, DM, WSP(bfu, WS_WOUT), nullptr, nullptr, r, lane); continue; } r -= J_OUT;
                    if (r < J_PG) { p0_transpose_item(INP(19), DM, DM, WSP(bfu, WS_WPG), INP(17), nullptr, r, lane); continue; } r -= J_PG;
                    p0_transpose_item(INP(18), PLE, DM, WSP(bfu, WS_WPLE), nullptr, nullptr, r, lane); }
                { const f32x4* p4 = (const f32x4*)INP(1); uint2* pb = (uint2*)WSP(bfu, WS_PB);
#pragma unroll
                  for (int k2 = 0; k2 < 4; ++k2) { const int i = ci * 2048 + k2 * 512 + (int)threadIdx.x; const f32x4 v = __builtin_nontemporal_load(p4 + i); pb[i] = make_uint2(pk2(v[0], v[1]), pk2(v[2], v[3])); } }
                __syncthreads(); continue; }
            const unsigned n = (pidx < 512u) ? (pidx >> 1) : pidx - 256u;
            if (n >= 768u) {
                const int pc = (int)(n - 768u);
#pragma unroll 1
                for (int k2 = 0; k2 < 2; ++k2) { const int i = pc * 1024 + k2 * 512 + (int)threadIdx.x; const int ch = i & 127, tb = (i >> 7) * 8, gidx = ch >> 5;
                    const bfu* up = Ub + ch * 8; bfu* pp = AB2 + 1024 + ch * 8;
                    if (gidx == 0) pool_item<2>(up, pp, tb); else if (gidx == 1) pool_item<4>(up, pp, tb); else if (gidx == 2) pool_item<8>(up, pp, tb); else pool_item<16>(up, pp, tb); }
                __syncthreads(); continue; }
            int qb, part, c_, h_; bool may_split;
            if (n < 512u) { qb = 31 - (int)(n >> 4); part = (int)((n >> 3) & 1u); c_ = (int)((n >> 2) & 1u); h_ = 4 + (int)(n & 3u); may_split = true; }
            else { const unsigned m_ = n - 512u; qb = 31 - (int)(m_ >> 3); part = 0; c_ = (int)((m_ >> 2) & 1u); h_ = (int)(m_ & 3u); may_split = false; }
            const int hq = c_ * 8 + h_;
            const float slope2 = __builtin_exp2f(-(float)(h_ + 1)) * 1.4426950408889634f;
            const float qa = __uint_as_float(__hip_atomic_load(nmax + hq * 2, __ATOMIC_RELAXED, __HIP_MEMORY_SCOPE_AGENT)), qc = __uint_as_float(__hip_atomic_load(nmax + hq * 2 + 1, __ATOMIC_RELAXED, __HIP_MEMORY_SCOPE_AGENT));
            const float ka = __uint_as_float(__hip_atomic_load(nmax + (16 + hq) * 2, __ATOMIC_RELAXED, __HIP_MEMORY_SCOPE_AGENT)), kc = __uint_as_float(__hip_atomic_load(nmax + (16 + hq) * 2 + 1, __ATOMIC_RELAXED, __HIP_MEMORY_SCOPE_AGENT));
            const float bt = sqrtf((qa + qc) * (ka + kc)) * 1.02f + 0.01f;
            const float dmin = fminf(ceilf((2.f * bt + 32.f - __builtin_log2f(1.f - __builtin_exp2f(-slope2))) / slope2), 1048576.f);
            int t0 = (qb * 256 - (int)dmin + 1); t0 = t0 > 0 ? (t0 >> 6) & ~1 : 0;
            t0 = __builtin_amdgcn_readfirstlane(t0);
            const float bref = __uint_as_float(__builtin_amdgcn_readfirstlane(__float_as_uint(fminf(bt, 60.f))));
            const int nt_all = 4 * qb + 4 - t0; const bool split = may_split && nt_all >= ATT_SPLIT_MIN; const int na = split ? (((nt_all >> 1) + 1) & ~1) : nt_all;
            if (part == 1 && !split) { __syncthreads(); continue; }
            attn_body::bf16* Od = (attn_body::bf16*)(Obase + (size_t)(c_ * 2 + part) * S * 1024); float* Ld = Lbase + (size_t)(c_ * 2 + part) * S * 8 + h_;
            if (part == 0 && !split && threadIdx.x < 256) Lbase[((size_t)(c_ * 2 + 1) * S + qb * 256 + threadIdx.x) * 8 + h_] = 0.f;
            if (part == 0) attn_body::attn_unit<8>(hq, 2 * h_, qb, (const attn_body::bf16*)Qb, (const attn_body::bf16*)Kb, (const attn_body::bf16*)Vb, Od, slope2, t0, na, !split, Ld, bref, (char*)lds);
            else attn_body::attn_unit<8>(hq, 2 * h_, qb, (const attn_body::bf16*)Qb, (const attn_body::bf16*)Kb, (const attn_body::bf16*)Vb, Od, slope2, t0 + na, nt_all - na, true, Ld, bref, (char*)lds);
        } }
    }
    GRID_BAR();

    {
        PHASE_IDS; DEF_WS; const float* lq1 = INP(4); const float* lk1 = INP(5); const float* lq2 = INP(6); const float* lk2 = INP(7); const float* subln_g = INP(8);
        bfu* Obase = (bfu*)OUTP; const float* Lbase = WSP(float, WS_SCR); bfu* AB2 = WSP(bfu, WS_AB2);
        const float d1 = wave_sum(lq1[lane] * lk1[lane]), d2 = wave_sum(lq2[lane] * lk2[lane]);
        const float lam = expf(d1) - expf(d2) + LAM_INIT;
        f32x4 sg[4];
#pragma unroll
        for (int j = 0; j < 4; ++j) sg[j] = ((const f32x4*)subln_g)[(lane & 7) * 4 + j] * (1.f - LAM_INIT);
        for (int m = gw; m < S; m += NGW) {
            float wgt[4];
#pragma unroll
            for (int cp = 0; cp < 4; ++cp) wgt[cp] = Lbase[((size_t)cp * S + m) * 8 + (lane >> 3)];
            const float i1 = 1.f / (wgt[0] + wgt[1]), i2 = 1.f / (wgt[2] + wgt[3]);
            const float w1a = wgt[0] * i1, w1b = wgt[1] * i1, w2a = -lam * wgt[2] * i2, w2b = -lam * wgt[3] * i2;
            const v4u* pa1 = (const v4u*)(Obase + ((size_t)0 * S + m) * 1024 + lane * 16); const v4u* pb1 = (const v4u*)(Obase + ((size_t)1 * S + m) * 1024 + lane * 16);
            const v4u* pa2 = (const v4u*)(Obase + ((size_t)2 * S + m) * 1024 + lane * 16); const v4u* pb2 = (const v4u*)(Obase + ((size_t)3 * S + m) * 1024 + lane * 16);
            f32x4 d[4]; float s = 0.f;
#pragma unroll
            for (int j = 0; j < 2; ++j) { f32x4 x0, x1, acc0 = (f32x4){0.f, 0.f, 0.f, 0.f}, acc1 = acc0;
                if (wgt[0] > 0.f) { pg8::unpack8(pa1[j], x0, x1); acc0 += x0 * w1a; acc1 += x1 * w1a; }
                if (wgt[1] > 0.f) { pg8::unpack8(pb1[j], x0, x1); acc0 += x0 * w1b; acc1 += x1 * w1b; }
                if (wgt[2] > 0.f) { pg8::unpack8(pa2[j], x0, x1); acc0 += x0 * w2a; acc1 += x1 * w2a; }
                if (wgt[3] > 0.f) { pg8::unpack8(pb2[j], x0, x1); acc0 += x0 * w2b; acc1 += x1 * w2b; }
                d[2 * j] = acc0; d[2 * j + 1] = acc1; s += pg8::sq4(acc0) + pg8::sq4(acc1); }
            s += __shfl_xor(s, 1); s += __shfl_xor(s, 2); s += __shfl_xor(s, 4);
            const float rs = 1.f / sqrtf(s * (1.f / 128.f) + NORM_EPS);
            v4u* o = (v4u*)(AB2 + (size_t)m * 2048 + lane * 16);
#pragma unroll
            for (int j = 0; j < 2; ++j) { const f32x4 v0 = d[2 * j] * rs * sg[2 * j], v1 = d[2 * j + 1] * rs * sg[2 * j + 1];
                v4u w; w.x = pk2(v0[0], v0[1]); w.y = pk2(v0[2], v0[3]); w.z = pk2(v1[0], v1[1]); w.w = pk2(v1[2], v1[3]); o[j] = w; }
        }
    }
    GRID_BAR();

    {
        PHASE_IDS; DEF_WS; bfu* AB2 = WSP(bfu, WS_AB2); bfu* WBR = WSP(bfu, WS_WBR); bfu* MG = WSP(bfu, WS_MG); bfu* GA = WSP(bfu, WS_G); bfu* GP = GA + (size_t)S * 2048;
        pg8::StaticOrder so; so.init(S, DM, G, bx);
        pg8::Gemm g1{AB2, WBR, S, DM, DM, DM, DM, 0, 0}; pg8::EpiMerged E1{GA, GP, MG};
        for (int rep_ = 0; rep_ < REP_P3; ++rep_) pg8::gemm_phase<pg8::EpiMerged, pg8::StaticOrder, true, true>(ldsp, g1, so, E1);
    }
    GRID_BAR();

    {
        PHASE_IDS; DEF_WS; float* out = OUTP; const float* x = INP(0); bfu* MG = WSP(bfu, WS_MG); bfu* WOUT = WSP(bfu, WS_WOUT); bfu* XB = WSP(bfu, WS_XB); float* ss1 = WSP(float, WS_SS);
        pg8::StaticOrder so; so.init(S, DM, G, bx);
        pg8::Gemm g1{MG, WOUT, S, DM, DM, DM, DM, 0, 0}; pg8::EpiResid<false> E1{x, XB, ss1};
        pg8::gemm_phase<pg8::EpiResid<false>, pg8::StaticOrder, true, true>(ldsp, g1, so, E1);
        for (int rep_ = 1; rep_ < REP_P4; ++rep_) { pg8::EpiResid<false> ER{x, XB, (float*)(ws + WS_BAR + 131072)}; pg8::gemm_phase<pg8::EpiResid<false>, pg8::StaticOrder, true, true>(ldsp, g1, so, ER); }
        for (int rep_ = 0; rep_ < REP_G4; ++rep_) { pg8::EpiDummy ED{WSP(bfu, WS_SCR)}; pg8::gemm_phase<pg8::EpiDummy, pg8::StaticOrder, true, true>(ldsp, g1, so, ED); }
    }
    GRID_BAR();

    {
        PHASE_IDS; DEF_WS; bfu* XB = WSP(bfu, WS_XB); bfu* WUP = WSP(bfu, WS_WUP); bfu* HB = WSP(bfu, WS_H); float* ss1 = WSP(float, WS_SS);
        pg8::StaticOrder so; so.init(S, FF, G, bx);
        pg8::Gemm g1{XB, WUP, S, FF, DM, DM, DM, 0, 0}; pg8::EpiUp E1{HB, ss1};
        for (int rep_ = 0; rep_ < REP_P5; ++rep_) pg8::gemm_phase<pg8::EpiUp, pg8::StaticOrder, true, true>(ldsp, g1, so, E1);
    }
    GRID_BAR();

    {
        PHASE_IDS; DEF_WS; float* out = OUTP; bfu* HB = WSP(bfu, WS_H); bfu* WDN = WSP(bfu, WS_WDN); bfu* XB = WSP(bfu, WS_XB); float* ss2 = WSP(float, WS_SS) + S;
        pg8::StaticOrder so; so.init(S, DM, G, bx);
        pg8::Gemm g1{HB, WDN, S, DM, FF, FF, FF, 0, 0}; pg8::EpiResid<true> E1{XB, XB, ss2};
        pg8::gemm_phase<pg8::EpiResid<true>, pg8::StaticOrder, true, true>(ldsp, g1, so, E1);
        for (int rep_ = 0; rep_ < REP_G6; ++rep_) { pg8::EpiDummy ED{WSP(bfu, WS_SCR)}; pg8::gemm_phase<pg8::EpiDummy, pg8::StaticOrder, true, true>(ldsp, g1, so, ED); }
    }
    GRID_BAR();

    {
        PHASE_IDS; DEF_WS; float* out = OUTP; bfu* PB = WSP(bfu, WS_PB); bfu* WPLE = WSP(bfu, WS_WPLE); bfu* PE = WSP(bfu, WS_PE); bfu* XB = WSP(bfu, WS_XB); bfu* WPG = WSP(bfu, WS_WPG);
        float* ss2 = WSP(float, WS_SS) + S; float* ss3 = ss2 + S;
        pg8::StaticOrder so; so.init(S, DM, G, bx);
        pg8::Gemm g1{PB, WPLE, S, DM, PLE, PLE, PLE, 0, 0}; pg8::EpiStoreBf16 E1{PE};
        pg8::gemm_phase<pg8::EpiStoreBf16, pg8::StaticOrder, true, true>(ldsp, g1, so, E1);
        pg8::Gemm g2{XB, WPG, S, DM, DM, DM, DM, 0, 0}; pg8::EpiPleGateFinal E2{PE, XB, out, ss2, ss3, (unsigned*)(WSP(float, WS_SS) + 3 * S) + 96, INP(20)};
        pg8::gemm_phase<pg8::EpiPleGateFinal, pg8::StaticOrder, false, true>(ldsp, g2, so, E2);
    }

    if (threadIdx.x == 0) __hip_atomic_store((unsigned long long*)(WSB + WS_FLAGS) + blockIdx.x, FLAG_CLOSED, __ATOMIC_RELAXED, __HIP_MEMORY_SCOPE_AGENT);
}

extern "C" void kernel_launch(void* const* d_in, const int* in_sizes, int n_in, void* d_out, int out_size, void* d_ws, size_t ws_size, hipStream_t stream) {
    static int grid_blocks = 0;
    if (grid_blocks == 0) {
        if (n_in != 21 || in_sizes[0] != S * DM || out_size != S * DM || ws_size < WS_END) { fprintf(stderr, "kernel_launch: unexpected shapes (n_in %d, in0 %d, out %d, ws %zu); nothing launched\n", n_in, n_in > 0 ? in_sizes[0] : -1, out_size, ws_size); grid_blocks = -1; return; }
        int dev = 0, cus = 0, per_cu = 0;
        (void)hipGetDevice(&dev); (void)hipDeviceGetAttribute(&cus, hipDeviceAttributeMultiprocessorCount, dev);
        if (hipFuncSetAttribute((const void*)fwd_megakernel, hipFuncAttributeMaxDynamicSharedMemorySize, LDS_BYTES) != hipSuccess) { fprintf(stderr, "kernel_launch: hipFuncSetAttribute failed\n"); grid_blocks = -1; return; }
        if (hipOccupancyMaxActiveBlocksPerMultiprocessor(&per_cu, (const void*)fwd_megakernel, NWAVES * 64, LDS_BYTES) != hipSuccess || per_cu < 1) { fprintf(stderr, "kernel_launch: occupancy query says %d\n", per_cu); per_cu = 1; }
        (void)hipGetLastError();
        grid_blocks = cus * 1;
        fprintf(stderr, "kernel_launch: cus %d per_cu %d grid %d\n", cus, per_cu, grid_blocks);
    }
    if (grid_blocks < 0) return;
    Args a{};
    for (int i = 0; i < 21; ++i) a.in[i] = (const float*)d_in[i];
    a.out = (float*)d_out; a.ws = (unsigned char*)d_ws;
    void* kargs[] = {&a};
    hipError_t e = hipLaunchCooperativeKernel((const void*)fwd_megakernel, dim3(grid_blocks), dim3(NWAVES * 64), kargs, LDS_BYTES, stream);
    if (e != hipSuccess) fprintf(stderr, "cooperative launch failed: %s (grid %d)\n", hipGetErrorString(e), grid_blocks);
}
```
